# Optimizing an MI355X kernel written in HIP

```python
import math
import jax, jax.numpy as jnp
from jax import lax
import numpy as np


D_MODEL = 1024
BATCH = 8
SEQ = 8192
DEPTH = 1

MEM_TOKENS = 256
S5_WIDTH = D_MODEL // 4
S5_GROUP_CH = 16
S5_GROUPS = S5_WIDTH // S5_GROUP_CH
S5_STATE = 64
S5_MAX_RE = -1e-4
S5_DT_MIN = 1e-3
S5_DT_MAX = 1e-1
MLA_HEADS = 8
MLA_NOPE_DIM = 64
MLA_ROPE_DIM = 32
MLA_QK_DIM = MLA_NOPE_DIM + MLA_ROPE_DIM
MLA_V_DIM = 64
MLA_Q_RANK = D_MODEL // 4
MLA_KV_RANK = D_MODEL // 4
ROPE_THETA = 10000.0
Q_BLOCK = 128
XATTN_HEADS = 4
XATTN_HEAD_DIM = D_MODEL // XATTN_HEADS
MLP_HIDDEN = 4 * D_MODEL
LN_EPS = 1e-5
RMS_EPS = 1e-6
NEG_INF = -1e30
POS_OFFSET_MAX = 4096
DN_ALPHA = (2.0 * DEPTH) ** 0.25
DN_BETA = (8.0 * DEPTH) ** -0.25
IN_S5 = S5_WIDTH
IN_Q = MLA_Q_RANK
IN_KV = MLA_KV_RANK
IN_KR = MLA_ROPE_DIM
IN_GATE = 2 * D_MODEL
IN_WIDTH = IN_S5 + IN_Q + IN_KV + IN_KR + IN_GATE

kernel_name = "hybrid_s5_mla_gated_deepnorm_layer"


def layer_norm(x, g, b):
    xf = x.astype(jnp.float32)
    mu = jnp.mean(xf, axis=-1, keepdims=True)
    xc = xf - mu
    var = jnp.mean(xc * xc, axis=-1, keepdims=True)
    return (xc * lax.rsqrt(var + LN_EPS) * g.astype(jnp.float32) + b.astype(jnp.float32)).astype(x.dtype)


def rms_norm(x, g):
    xf = x.astype(jnp.float32)
    return (xf * lax.rsqrt(jnp.mean(xf * xf, axis=-1, keepdims=True) + RMS_EPS) * g.astype(jnp.float32)).astype(x.dtype)


def rope_tables(positions):
    inv = ROPE_THETA ** (-jnp.arange(0, MLA_ROPE_DIM, 2, dtype=jnp.float32) / MLA_ROPE_DIM)
    ang = positions.astype(jnp.float32)[..., None] * inv
    return jnp.cos(ang)[:, :, None, :], jnp.sin(ang)[:, :, None, :]


def apply_rope(x, cos, sin):
    xf = x.astype(jnp.float32)
    x1, x2 = jnp.split(xf, 2, axis=-1)
    return jnp.concatenate([x1 * cos - x2 * sin, x1 * sin + x2 * cos], axis=-1).astype(x.dtype)


def _complex_scan_op(e1, e2):
    a1r, a1i, b1r, b1i = e1
    a2r, a2i, b2r, b2i = e2
    ar = a1r * a2r - a1i * a2i
    ai = a1r * a2i + a1i * a2r
    br = a2r * b1r - a2i * b1i + b2r
    bi = a2r * b1i + a2i * b1r + b2i
    return (ar, ai, br, bi)


def s5_ssm(u, lam_re, lam_im, log_dt, b_re, b_im, c_re, c_im, d_skip):
    bsz, seq, _ = u.shape
    uf = u.astype(jnp.float32).reshape(bsz, seq, S5_GROUPS, S5_GROUP_CH)
    lr = jnp.minimum(lam_re.astype(jnp.float32), S5_MAX_RE)
    li = lam_im.astype(jnp.float32)
    dt = jnp.exp(log_dt.astype(jnp.float32))[:, None]
    mag = jnp.exp(lr * dt)
    ang = li * dt
    ab_re = mag * jnp.cos(ang)
    ab_im = mag * jnp.sin(ang)
    den = lr * lr + li * li
    nr = ab_re - 1.0
    f_re = ((nr * lr + ab_im * li) / den)[..., None]
    f_im = ((ab_im * lr - nr * li) / den)[..., None]
    br = b_re.astype(jnp.float32)
    bi = b_im.astype(jnp.float32)
    bb_re = f_re * br - f_im * bi
    bb_im = f_re * bi + f_im * br
    bu_re = jnp.einsum('bsgh,gph->bsgp', uf, bb_re)
    bu_im = jnp.einsum('bsgh,gph->bsgp', uf, bb_im)
    a_re = jnp.broadcast_to(ab_re[None, None], (1, seq, S5_GROUPS, S5_STATE))
    a_im = jnp.broadcast_to(ab_im[None, None], (1, seq, S5_GROUPS, S5_STATE))
    _, _, h_re, h_im = lax.associative_scan(_complex_scan_op, (a_re, a_im, bu_re, bu_im), axis=1)
    y = (jnp.einsum('bsgp,ghp->bsgh', h_re, c_re.astype(jnp.float32))
         - jnp.einsum('bsgp,ghp->bsgh', h_im, c_im.astype(jnp.float32)))
    y = y + d_skip.astype(jnp.float32).reshape(S5_GROUPS, S5_GROUP_CH) * uf
    return y.reshape(bsz, seq, S5_WIDTH)


def causal_block_attention(q, k, v):
    bsz, seq, heads, dqk = q.shape
    nblk = seq // Q_BLOCK
    scale = dqk ** -0.5
    qb = jnp.moveaxis(q.reshape(bsz, nblk, Q_BLOCK, heads, dqk), 1, 0)
    starts = jnp.arange(nblk, dtype=jnp.int32) * Q_BLOCK
    kpos = jnp.arange(seq, dtype=jnp.int32)

    def block(args):
        qi, start = args
        s = jnp.einsum('bqhd,bkhd->bhqk', qi, k).astype(jnp.float32) * scale
        qpos = start + jnp.arange(Q_BLOCK, dtype=jnp.int32)
        s = jnp.where(kpos[None, :] <= qpos[:, None], s, NEG_INF)
        p = jax.nn.softmax(s, axis=-1).astype(v.dtype)
        return jnp.einsum('bhqk,bkhd->bqhd', p, v)

    o = lax.map(block, (qb, starts))
    return jnp.moveaxis(o, 0, 1).reshape(bsz, seq, heads * v.shape[-1])


def hybrid_mixer(h, cos, sin, w_in, s5_lam_re, s5_lam_im, s5_log_dt, s5_b_re, s5_b_im,
                 s5_c_re, s5_c_im, s5_d, w_glu, q_norm_g, w_uq, kv_norm_g, w_ukv, w_oa, w_o):
    bsz, seq, _ = h.shape
    z = h @ w_in
    o1 = IN_S5
    o2 = o1 + IN_Q
    o3 = o2 + IN_KV
    o4 = o3 + IN_KR
    u = z[..., :o1]
    c_q = z[..., o1:o2]
    c_kv = z[..., o2:o3]
    k_r = z[..., o3:o4]
    gate = z[..., o4:]
    y = s5_ssm(u, s5_lam_re, s5_lam_im, s5_log_dt, s5_b_re, s5_b_im, s5_c_re, s5_c_im, s5_d).astype(h.dtype)
    y = jax.nn.gelu(y, approximate=False) @ w_glu
    s_out = y[..., :D_MODEL] * jax.nn.sigmoid(y[..., D_MODEL:])
    q = (rms_norm(c_q, q_norm_g) @ w_uq).reshape(bsz, seq, MLA_HEADS, MLA_QK_DIM)
    q = jnp.concatenate([q[..., :MLA_NOPE_DIM], apply_rope(q[..., MLA_NOPE_DIM:], cos, sin)], axis=-1)
    kv = (rms_norm(c_kv, kv_norm_g) @ w_ukv).reshape(bsz, seq, MLA_HEADS, MLA_NOPE_DIM + MLA_V_DIM)
    k_rope = apply_rope(k_r[:, :, None, :], cos, sin)
    k = jnp.concatenate([kv[..., :MLA_NOPE_DIM],
                         jnp.broadcast_to(k_rope, (bsz, seq, MLA_HEADS, MLA_ROPE_DIM))], axis=-1)
    v = kv[..., MLA_NOPE_DIM:]
    a_out = causal_block_attention(q, k, v) @ w_oa
    g_s = jax.nn.sigmoid(gate[..., :D_MODEL])
    g_a = jax.nn.sigmoid(gate[..., D_MODEL:])
    return (g_s * s_out + g_a * a_out) @ w_o


def memory_cross_attention(h, mem, w_xq, w_xk, w_xv, w_xo):
    bsz, seq, _ = h.shape
    m = mem.shape[1]
    q = (h @ w_xq).reshape(bsz, seq, XATTN_HEADS, XATTN_HEAD_DIM)
    k = (mem @ w_xk).reshape(bsz, m, XATTN_HEADS, XATTN_HEAD_DIM)
    v = (mem @ w_xv).reshape(bsz, m, XATTN_HEADS, XATTN_HEAD_DIM)
    s = jnp.einsum('bshd,bmhd->bhsm', q, k).astype(jnp.float32) * (XATTN_HEAD_DIM ** -0.5)
    p = jax.nn.softmax(s, axis=-1).astype(v.dtype)
    o = jnp.einsum('bhsm,bmhd->bshd', p, v).reshape(bsz, seq, D_MODEL)
    return o @ w_xo


def squared_relu_mlp(h, w_up, w_down):
    return jnp.square(jax.nn.relu(h @ w_up)) @ w_down


def setup_inputs(seed: int = 0) -> dict:
    key = jax.random.key(seed)
    ks = jax.random.split(key, 40)
    f32 = jnp.float32

    def nrm(k, shape, scale):
        return jax.random.normal(k, shape, f32) * scale

    L = DEPTH
    G, P, H = S5_GROUPS, S5_STATE, S5_GROUP_CH
    n = jnp.arange(P, dtype=f32)
    positions = (jax.random.randint(ks[2], (BATCH, 1), 0, POS_OFFSET_MAX, dtype=jnp.int32)
                 + jnp.arange(SEQ, dtype=jnp.int32)[None, :])
    return {
        "x": nrm(ks[0], (BATCH, SEQ, D_MODEL), 1.0),
        "mem": nrm(ks[1], (BATCH, MEM_TOKENS, D_MODEL), 1.0),
        "positions": positions,
        "ln_in_g": 1.0 + nrm(ks[3], (D_MODEL,), 0.02),
        "ln_in_b": nrm(ks[4], (D_MODEL,), 0.02),
        "w_in": nrm(ks[5], (L, D_MODEL, IN_WIDTH), D_MODEL ** -0.5),
        "s5_lam_re": -0.5 + nrm(ks[6], (L, G, P), 0.01),
        "s5_lam_im": math.pi * n + nrm(ks[7], (L, G, P), 0.01),
        "s5_log_dt": jax.random.uniform(ks[8], (L, G), f32, math.log(S5_DT_MIN), math.log(S5_DT_MAX)),
        "s5_b_re": nrm(ks[9], (L, G, P, H), (2.0 * H) ** -0.5),
        "s5_b_im": nrm(ks[10], (L, G, P, H), (2.0 * H) ** -0.5),
        "s5_c_re": nrm(ks[11], (L, G, H, P), P ** -0.5),
        "s5_c_im": nrm(ks[12], (L, G, H, P), P ** -0.5),
        "s5_d": nrm(ks[13], (L, S5_WIDTH), 1.0),
        "w_glu": nrm(ks[14], (L, S5_WIDTH, 2 * D_MODEL), S5_WIDTH ** -0.5),
        "q_norm_g": 1.0 + nrm(ks[15], (L, MLA_Q_RANK), 0.02),
        "w_uq": nrm(ks[16], (L, MLA_Q_RANK, MLA_HEADS * MLA_QK_DIM), MLA_Q_RANK ** -0.5),
        "kv_norm_g": 1.0 + nrm(ks[17], (L, MLA_KV_RANK), 0.02),
        "w_ukv": nrm(ks[18], (L, MLA_KV_RANK, MLA_HEADS * (MLA_NOPE_DIM + MLA_V_DIM)), MLA_KV_RANK ** -0.5),
        "w_oa": nrm(ks[19], (L, MLA_HEADS * MLA_V_DIM, D_MODEL), (MLA_HEADS * MLA_V_DIM) ** -0.5),
        "w_o": nrm(ks[20], (L, D_MODEL, D_MODEL), DN_BETA * D_MODEL ** -0.5),
        "ln1_g": 1.0 + nrm(ks[21], (L, D_MODEL), 0.02),
        "ln1_b": nrm(ks[22], (L, D_MODEL), 0.02),
        "w_xq": nrm(ks[23], (L, D_MODEL, D_MODEL), D_MODEL ** -0.5),
        "w_xk": nrm(ks[24], (L, D_MODEL, D_MODEL), D_MODEL ** -0.5),
        "w_xv": nrm(ks[25], (L, D_MODEL, D_MODEL), DN_BETA * D_MODEL ** -0.5),
        "w_xo": nrm(ks[26], (L, D_MODEL, D_MODEL), DN_BETA * D_MODEL ** -0.5),
        "ln2_g": 1.0 + nrm(ks[27], (L, D_MODEL), 0.02),
        "ln2_b": nrm(ks[28], (L, D_MODEL), 0.02),
        "w_up": nrm(ks[29], (L, D_MODEL, MLP_HIDDEN), DN_BETA * D_MODEL ** -0.5),
        "w_down": nrm(ks[30], (L, MLP_HIDDEN, D_MODEL), DN_BETA * MLP_HIDDEN ** -0.5),
        "ln3_g": 1.0 + nrm(ks[31], (L, D_MODEL), 0.02),
        "ln3_b": nrm(ks[32], (L, D_MODEL), 0.02),
    }


def reference(x, mem, positions, ln_in_g, ln_in_b, w_in, s5_lam_re, s5_lam_im, s5_log_dt,
              s5_b_re, s5_b_im, s5_c_re, s5_c_im, s5_d, w_glu, q_norm_g, w_uq, kv_norm_g, w_ukv,
              w_oa, w_o, ln1_g, ln1_b, w_xq, w_xk, w_xv, w_xo, ln2_g, ln2_b, w_up, w_down,
              ln3_g, ln3_b):
    cos, sin = rope_tables(positions)
    h = layer_norm(x, ln_in_g, ln_in_b)
    for l in range(DEPTH):
        mix = hybrid_mixer(h, cos, sin, w_in[l], s5_lam_re[l], s5_lam_im[l], s5_log_dt[l],
                           s5_b_re[l], s5_b_im[l], s5_c_re[l], s5_c_im[l], s5_d[l], w_glu[l],
                           q_norm_g[l], w_uq[l], kv_norm_g[l], w_ukv[l], w_oa[l], w_o[l])
        h = layer_norm(DN_ALPHA * h + mix, ln1_g[l], ln1_b[l])
        xa = memory_cross_attention(h, mem, w_xq[l], w_xk[l], w_xv[l], w_xo[l])
        h = layer_norm(DN_ALPHA * h + xa, ln2_g[l], ln2_b[l])
        ff = squared_relu_mlp(h, w_up[l], w_down[l])
        h = layer_norm(DN_ALPHA * h + ff, ln3_g[l], ln3_b[l])
    return h
```

```cpp
#include <hip/hip_runtime.h>
#include <hip/hip_cooperative_groups.h>
#include <cstdio>
#include <cstdint>
namespace cg = cooperative_groups;

#define LAS __attribute__((address_space(3)))
#define DI __device__ __forceinline__
typedef unsigned short bf16_t;
typedef short bf16x8 __attribute__((ext_vector_type(8)));
typedef short s16x4 __attribute__((ext_vector_type(4)));
typedef float f32x2 __attribute__((ext_vector_type(2)));
typedef float f32x4 __attribute__((ext_vector_type(4)));
typedef float f32x16 __attribute__((ext_vector_type(16)));
typedef unsigned u32x2 __attribute__((ext_vector_type(2)));
typedef unsigned u32x4 __attribute__((ext_vector_type(4)));
typedef __bf16 bf16x2_t __attribute__((ext_vector_type(2)));

constexpr int BATCH = 8, SEQ = 8192, T = BATCH * SEQ, D = 1024;
constexpr int ZW = 3072;
constexpr int Z_U = 0, Z_CQ = 256, Z_CKV = 512, Z_KR = 768, Z_GS = 800, Z_GA = 1824;
constexpr int MEMT = 256;
constexpr int NCHUNK = 16, CHUNK = SEQ / NCHUNK;
constexpr float LN_EPS = 1e-5f, RMS_EPS = 1e-6f;
constexpr float DN_ALPHA = 1.189207115002721f;
constexpr float LOG2E = 1.4426950408889634f;
constexpr int NTHREADS = 512, NWAVES = 8;
constexpr int LDS_BYTES = 147456;
constexpr int LDS_XCH = 131072;

constexpr size_t MiB = 1ull << 20;
constexpr size_t WS_STAT0 = 1 * MiB, WS_RMS = 1 * MiB + 512 * 1024, WS_STAT1 = 2 * MiB, WS_STAT2 = 2 * MiB + 512 * 1024;
constexpr size_t WS_RS4 = 3 * MiB;
constexpr size_t WS_E = 7 * MiB;
constexpr size_t WS_CS = 8 * MiB;
constexpr size_t WS_KR = 16 * MiB;
constexpr size_t WS_MEMB = 20 * MiB;
constexpr size_t WS_KVX = 24 * MiB;
constexpr size_t WS_VXT = 32 * MiB;
constexpr size_t WS_S5T = 36 * MiB;
constexpr size_t WS_W = 40 * MiB;
constexpr size_t W_IN = WS_W, W_GLU = W_IN + 6 * MiB, W_UQ = W_GLU + 1 * MiB, W_UKV = W_UQ + 512 * 1024, W_OA = W_UKV + 512 * 1024,
                 W_O = W_OA + 1 * MiB, W_XQ = W_O + 2 * MiB, W_XKV = W_XQ + 2 * MiB, W_XO = W_XKV + 4 * MiB, W_UP = W_XO + 2 * MiB, W_DOWN = W_UP + 8 * MiB;
static_assert(W_DOWN + 8 * MiB <= 80 * MiB, "weights");
constexpr size_t WS_Z = 80 * MiB;
constexpr size_t WS_HN = 464 * MiB;
constexpr size_t WS_SG = 464 * MiB;
constexpr size_t WS_Q = 592 * MiB;
constexpr size_t WS_KV = 688 * MiB;
constexpr size_t WS_YG = 816 * MiB;
constexpr size_t WS_ATT = 848 * MiB;
constexpr size_t WS_GATED = 592 * MiB;
constexpr size_t WS_R1 = 80 * MiB;
constexpr size_t WS_H1B = 336 * MiB;
constexpr size_t WS_XQ = 464 * MiB;
constexpr size_t WS_P = 592 * MiB;
constexpr size_t WS_XOIN = 336 * MiB;
constexpr size_t WS_R2 = 720 * MiB;
constexpr size_t WS_H2B = 592 * MiB;
constexpr size_t WS_HID = 80 * MiB;
constexpr size_t WS_END = 1024 * MiB;

constexpr size_t S5_ABAR = 0;
constexpr size_t S5_APOW = 8192;
constexpr size_t S5_BHI = 16384;
constexpr size_t S5_BLO = S5_BHI + 65536;
constexpr size_t S5_CHI = S5_BLO + 65536;
constexpr size_t S5_CLO = S5_CHI + 65536;

DI unsigned cvtpk(float lo, float hi) { f32x2 v = {lo, hi}; bf16x2_t b = __builtin_convertvector(v, bf16x2_t); return __builtin_bit_cast(unsigned, b); }
DI float bf2f(unsigned short u) { return __uint_as_float((unsigned)u << 16); }
DI float bflo(unsigned u) { return __uint_as_float(u << 16); }
DI float bfhi(unsigned u) { return __uint_as_float(u & 0xffff0000u); }
DI bf16_t f2bf(float f) { return (bf16_t)(cvtpk(f, 0.f) & 0xffffu); }
DI float sigmoidf_(float x) { return 1.0f / (1.0f + __expf(-x)); }
DI int crow(int r, int hi) { return (r & 3) + 8 * (r >> 2) + 4 * hi; }
DI float wave_sum(float v) {
#pragma unroll
    for (int o = 1; o < 64; o <<= 1) v += __shfl_xor(v, o);
    return v;
}
#define LDS_WAIT() asm volatile("s_waitcnt lgkmcnt(0)" ::: "memory")
#define CFENCE() asm volatile("" ::: "memory")
DI int lane_id() { int l; asm volatile("v_mbcnt_lo_u32_b32 %0, -1, 0\n\tv_mbcnt_hi_u32_b32 %0, -1, %0" : "=v"(l)); return l; }
DI void sincos_d(double x, double& s, double& c) {
    const double TWO_PI = 6.283185307179586476925287;
    const double k = rint(x / TWO_PI); const double r = x - k * TWO_PI;
    const double q = r * 0.25, q2 = q * q;
    double ss = q * (1.0 - q2 / 6.0 * (1.0 - q2 / 20.0 * (1.0 - q2 / 42.0 * (1.0 - q2 / 72.0 * (1.0 - q2 / 110.0 * (1.0 - q2 / 156.0 * (1.0 - q2 / 210.0)))))));
    double cc = 1.0 - q2 / 2.0 * (1.0 - q2 / 12.0 * (1.0 - q2 / 30.0 * (1.0 - q2 / 56.0 * (1.0 - q2 / 90.0 * (1.0 - q2 / 132.0 * (1.0 - q2 / 182.0))))));
    const double s2 = 2.0 * ss * cc, c2 = 1.0 - 2.0 * ss * ss;
    s = 2.0 * s2 * c2; c = 1.0 - 2.0 * s2 * s2;
}
DI double exp_d(double x) {
    const double LN2 = 0.693147180559945309417232;
    const double k = rint(x / LN2); const double r = x - k * LN2;
    double p = 1.0;
#pragma unroll
    for (int i = 16; i >= 1; --i) p = 1.0 + p * r / (double)i;
    const long long e = (long long)k + 1023; const double sc = __longlong_as_double(e << 52);
    return p * sc;
}

DI void grid_barrier(unsigned* ctr, unsigned target, int wid) {
    asm volatile("s_waitcnt vmcnt(0) lgkmcnt(0)" ::: "memory");
    __syncthreads();
    if (wid == 0) {
        const int lane = lane_id();
        if (lane == 0) {
            __builtin_amdgcn_fence(__ATOMIC_RELEASE, "agent");
            asm volatile("s_waitcnt vmcnt(0)" ::: "memory");
            __hip_atomic_fetch_add(ctr, 1u, __ATOMIC_RELAXED, __HIP_MEMORY_SCOPE_AGENT);
            while (__hip_atomic_load(ctr, __ATOMIC_RELAXED, __HIP_MEMORY_SCOPE_AGENT) < target) __builtin_amdgcn_s_sleep(4);
            __builtin_amdgcn_fence(__ATOMIC_ACQUIRE, "agent");
            asm volatile("s_waitcnt vmcnt(0)" ::: "memory");
        }
    }
    __syncthreads();
}

namespace pg8 {
constexpr int BM = 256, BK = 64, HALF = 128, HTB = HALF * BK * 2, STAGE_BYTES = 8 * HTB, NXCD = 8, WGM = 8;
DI int lds_byte(int r, int c) { const int st = (r >> 4) * 2 + (c >> 5), rr = r & 15, cc = c & 31, ob = rr * 64 + cc * 2; return st * 1024 + (ob ^ (((ob >> 9) & 1) << 5)); }
DI void stage_rc(int b, int& R, int& C) { const int st = b / 1024, sb = b % 1024, swz = sb ^ (((sb >> 9) & 1) << 5); R = (st >> 1) * 16 + swz / 64; C = (st & 1) * 32 + (swz % 64) / 2; }
DI int perm32(int rho) { const int n = rho >> 4, i = rho & 15; return 8 * (i >> 2) + 4 * n + (i & 3); }

struct Unit { int pm, pn; long ao, bo; };
struct Gemm { const bf16_t* A; const bf16_t* Bt; int lda, ldb, K; };

struct StdOrder {
    int nM, nN, nwg, G, c, lda, ldb;
    DI void init(int M, int N, int lda_, int ldb_, int G_, int c_) { nM = M / BM; nN = N / BM; nwg = nM * nN; G = G_; c = c_; lda = lda_; ldb = ldb_; }
    DI bool next(int i, Unit& u) const {
        const long L = (long)i * G + c; if (L >= nwg) return false;
        int wgid = (int)L; { const int q = nwg / NXCD, r = nwg % NXCD, xcd = wgid % NXCD, off = wgid / NXCD; wgid = (xcd < r ? xcd * (q + 1) : r * (q + 1) + (xcd - r) * q) + off; }
        const int nig = WGM * nN, gid = wgid / nig, fm = gid * WGM, gsz = (nM - fm) < WGM ? (nM - fm) : WGM;
        u.pm = fm + ((wgid % nig) % gsz); u.pn = (wgid % nig) / gsz;
        u.ao = (long)u.pm * BM * lda; u.bo = (long)u.pn * BM * ldb; return true;
    }
};
struct XattnOrder {
    int G, c, lda; long bstride_b, bstride_h;
    DI bool next(int i, Unit& u) const {
        const long L = (long)i * G + c; if (L >= 1024) return false;
        const int bh = (int)L >> 5, pml = (int)L & 31, b = bh >> 2, h = bh & 3;
        u.pm = b * 32 + pml; u.pn = h;
        u.ao = (long)u.pm * BM * lda + h * 256; u.bo = (long)b * bstride_b + (long)h * bstride_h; return true;
    }
};

typedef f32x4 Acc[2][2][4][2];

template <class Epi, class Sched, bool ALIGN_EPI>
DI void gemm_phase(LAS unsigned char* lds, const int wid, const Gemm g, const Sched& S, const Epi& E) {
    const int lane = lane_id(), tid = wid * 64 + lane, wr = wid >> 2, wc = wid & 3, fr = lane & 15, fq = lane >> 4;
    const int K = g.K, nt = K / BK;
    unsigned voffA[2], voffB[2];
#pragma unroll
    for (int i = 0; i < 2; ++i) { int R, C; stage_rc(tid * 16 + i * 8192, R, C); const int Rb = Epi::PERM ? ((R & ~31) + perm32(R & 31)) : R;
        voffA[i] = (unsigned)(R * g.lda + C) * 2u; voffB[i] = (unsigned)(Rb * g.ldb + C) * 2u; }
    const size_t kstep = (size_t)(BK * 2);
    const size_t hstepA = (size_t)HALF * g.lda * 2, hstepB = (size_t)HALF * g.ldb * 2;
    const unsigned ldsw = (unsigned)wid * 1024u;
    const int aoff = lds_byte(wr * 64 + fr, fq * 8), boff = lds_byte(wc * 32 + fr, fq * 8);
#define PG8_SA(b, h) (((b) * 2 + (h)) * HTB)
#define PG8_SB(b, h) ((4 + (b) * 2 + (h)) * HTB)
#define PG8_STAGE(bufoff, gbase, voff) do { _Pragma("unroll") for (int _i = 0; _i < 2; ++_i) \
        __builtin_amdgcn_global_load_lds((const unsigned*)((const char*)(gbase) + (voff)[_i]), (LAS unsigned*)(lds + (bufoff) + ldsw + _i * 8192), 16, 0, 0); } while (0)
#define PG8_LDA(dst, b, h) do { _Pragma("unroll") for (int m = 0; m < 4; ++m) _Pragma("unroll") for (int k = 0; k < 2; ++k) dst[m][k] = *(const LAS bf16x8*)(lds + PG8_SA(b, h) + aoff + m * 2048 + k * 1024); } while (0)
#define PG8_LDB(dst, b, h) do { _Pragma("unroll") for (int n = 0; n < 2; ++n) _Pragma("unroll") for (int k = 0; k < 2; ++k) dst[n][k] = *(const LAS bf16x8*)(lds + PG8_SB(b, h) + boff + n * 2048 + k * 1024); } while (0)
#define PG8_MMA(ai, bj, At, Bt) do { __builtin_amdgcn_s_setprio(1); _Pragma("unroll") for (int m = 0; m < 4; ++m) _Pragma("unroll") for (int n = 0; n < 2; ++n) _Pragma("unroll") for (int k = 0; k < 2; ++k) \
        acc[ai][bj][m][n] = __builtin_amdgcn_mfma_f32_16x16x32_bf16(Bt[n][k], At[m][k], acc[ai][bj][m][n], 0, 0, 0); __builtin_amdgcn_s_setprio(0); } while (0)
#define PG8_WAIT_V(n) asm volatile("s_waitcnt vmcnt(" #n ")" ::: "memory")
#define PG8_WAIT_L(n) asm volatile("s_waitcnt lgkmcnt(" #n ")" ::: "memory")
#define PG8_BAR __builtin_amdgcn_s_barrier()
#define PG8_SCHED __builtin_amdgcn_sched_barrier(0)
    Unit cur, nxt; int ui = 0;
    if (!S.next(0, cur)) return;
    Acc acc;
#pragma unroll
    for (int a = 0; a < 2; ++a)
#pragma unroll
        for (int b = 0; b < 2; ++b)
#pragma unroll
            for (int m = 0; m < 4; ++m)
#pragma unroll
                for (int n = 0; n < 2; ++n) acc[a][b][m][n] = (f32x4){0.f, 0.f, 0.f, 0.f};
    bf16x8 At[4][2], B0[2][2], B1[2][2];
    const char* cA = (const char*)g.A + cur.ao * 2; const char* cB = (const char*)g.Bt + cur.bo * 2;
    PG8_STAGE(PG8_SB(0, 0), cB, voffB); PG8_STAGE(PG8_SB(0, 1), cB + hstepB, voffB); PG8_STAGE(PG8_SA(0, 0), cA, voffA); PG8_STAGE(PG8_SA(0, 1), cA + hstepA, voffA);
    if (wr == 1) PG8_BAR;
    PG8_WAIT_V(2); PG8_BAR;
    PG8_STAGE(PG8_SB(1, 0), cB + kstep, voffB); PG8_STAGE(PG8_SA(1, 0), cA + kstep, voffA); PG8_STAGE(PG8_SB(1, 1), cB + hstepB + kstep, voffB);
    PG8_WAIT_V(6); PG8_BAR;
    for (;;) {
        const bool has_next = S.next(ui + 1, nxt);
        const char* nA = has_next ? (const char*)g.A + nxt.ao * 2 : cA; const char* nB = has_next ? (const char*)g.Bt + nxt.bo * 2 : cB;
        for (int t = 0; t < nt; t += 2) {
            const bool last = (t == nt - 2);
            const char* a1 = cA + (size_t)(t + 1) * kstep;
            const char* a2 = last ? nA : cA + (size_t)(t + 2) * kstep; const char* b2 = last ? nB : cB + (size_t)(t + 2) * kstep;
            const char* a3 = a2 + kstep; const char* b3 = b2 + kstep;
            PG8_LDB(B0, 0, 0); PG8_LDB(B1, 0, 1); PG8_SCHED; PG8_LDA(At, 0, 0); PG8_STAGE(PG8_SA(1, 1), a1 + hstepA, voffA);
            PG8_WAIT_V(8); PG8_WAIT_L(0); PG8_BAR; PG8_MMA(0, 0, At, B0); PG8_MMA(0, 1, At, B1); PG8_BAR; PG8_SCHED;
            PG8_LDA(At, 0, 1); PG8_STAGE(PG8_SB(0, 0), b2, voffB); PG8_STAGE(PG8_SB(0, 1), b2 + hstepB, voffB); PG8_STAGE(PG8_SA(0, 0), a2, voffA);
            PG8_WAIT_V(8); PG8_WAIT_L(0); PG8_BAR; PG8_MMA(1, 0, At, B0); PG8_MMA(1, 1, At, B1); PG8_BAR; PG8_SCHED;
            PG8_LDB(B0, 1, 0); PG8_LDB(B1, 1, 1); PG8_SCHED; PG8_LDA(At, 1, 0); PG8_STAGE(PG8_SA(0, 1), a2 + hstepA, voffA);
            PG8_WAIT_V(8); PG8_WAIT_L(0); PG8_BAR; PG8_MMA(0, 0, At, B0); PG8_MMA(0, 1, At, B1); PG8_BAR; PG8_SCHED;
            PG8_LDA(At, 1, 1); PG8_STAGE(PG8_SB(1, 0), b3, voffB); PG8_STAGE(PG8_SB(1, 1), b3 + hstepB, voffB); PG8_STAGE(PG8_SA(1, 0), a3, voffA);
            PG8_WAIT_V(8); PG8_WAIT_L(0); PG8_BAR; PG8_MMA(1, 0, At, B0); PG8_MMA(1, 1, At, B1); PG8_BAR; PG8_SCHED;
        }
        if constexpr (ALIGN_EPI) { if (wr == 0) PG8_BAR; }
        E(acc, cur, wr, wc, fr, fq, lds);
        if (!has_next) break;
#pragma unroll
        for (int a = 0; a < 2; ++a)
#pragma unroll
            for (int b = 0; b < 2; ++b)
#pragma unroll
                for (int m = 0; m < 4; ++m)
#pragma unroll
                    for (int n = 0; n < 2; ++n) acc[a][b][m][n] = (f32x4){0.f, 0.f, 0.f, 0.f};
        cur = nxt; cA = nA; cB = nB; ++ui;
        if constexpr (ALIGN_EPI) { if (wr == 1) PG8_BAR; }
    }
    PG8_WAIT_V(0);
    if constexpr (!ALIGN_EPI) { if (wr == 0) PG8_BAR; }
    PG8_BAR;
#undef PG8_SA
#undef PG8_SB
#undef PG8_STAGE
#undef PG8_LDA
#undef PG8_LDB
#undef PG8_MMA
#undef PG8_WAIT_V
#undef PG8_WAIT_L
#undef PG8_BAR
#undef PG8_SCHED
}

struct EpiStore {
    static constexpr bool PERM = true;
    bf16_t* O; int ldc; float scale; const float* rowscale; int rs_stride;
    DI void operator()(const Acc& acc, const Unit& u, int wr, int wc, int fr, int fq, LAS unsigned char*) const {
        const int row0 = u.pm * BM + wr * 64 + fr, col0 = u.pn * BM + wc * 32 + 8 * fq;
#pragma unroll
        for (int ai = 0; ai < 2; ++ai)
#pragma unroll
            for (int m = 0; m < 4; ++m) { const int row = row0 + ai * HALF + m * 16; bf16_t* rowp = O + (size_t)row * ldc + col0;
                const float sc = rowscale ? scale * rowscale[(size_t)row * rs_stride] : scale;
#pragma unroll
                for (int bj = 0; bj < 2; ++bj) { const f32x4 v0 = acc[ai][bj][m][0] * sc, v1 = acc[ai][bj][m][1] * sc;
                    u32x4 w; w.x = cvtpk(v0[0], v0[1]); w.y = cvtpk(v0[2], v0[3]); w.z = cvtpk(v1[0], v1[1]); w.w = cvtpk(v1[2], v1[3]);
                    *(u32x4*)(rowp + bj * HALF) = w; } CFENCE(); }
    }
};
struct EpiRelu2 {
    static constexpr bool PERM = true;
    bf16_t* O; int ldc;
    DI void operator()(const Acc& acc, const Unit& u, int wr, int wc, int fr, int fq, LAS unsigned char*) const {
        const int row0 = u.pm * BM + wr * 64 + fr, col0 = u.pn * BM + wc * 32 + 8 * fq;
#pragma unroll
        for (int ai = 0; ai < 2; ++ai)
#pragma unroll
            for (int m = 0; m < 4; ++m) { bf16_t* rowp = O + (size_t)(row0 + ai * HALF + m * 16) * ldc + col0;
#pragma unroll
                for (int bj = 0; bj < 2; ++bj) { f32x4 v0 = acc[ai][bj][m][0], v1 = acc[ai][bj][m][1];
#pragma unroll
                    for (int j = 0; j < 4; ++j) { const float a = fmaxf(v0[j], 0.f), b = fmaxf(v1[j], 0.f); v0[j] = a * a; v1[j] = b * b; }
                    u32x4 w; w.x = cvtpk(v0[0], v0[1]); w.y = cvtpk(v0[2], v0[3]); w.z = cvtpk(v1[0], v1[1]); w.w = cvtpk(v1[2], v1[3]);
                    *(u32x4*)(rowp + bj * HALF) = w; } CFENCE(); }
    }
};
struct EpiQ {
    static constexpr bool PERM = false;
    bf16_t* O; const float* rms; const float* cs; float scale;
    DI void operator()(const Acc& acc, const Unit& u, int wr, int wc, int fr, int fq, LAS unsigned char*) const {
#pragma unroll
        for (int ai = 0; ai < 2; ++ai)
#pragma unroll
            for (int m = 0; m < 4; ++m) { const int row = u.pm * BM + ai * HALF + wr * 64 + m * 16 + fr;
                const float sc = rms[(size_t)row * 2] * scale;
                const f32x4 cv0 = *(const f32x4*)(cs + (size_t)row * 32 + 8 * fq), cv1 = *(const f32x4*)(cs + (size_t)row * 32 + 8 * fq + 4);
                const float cc[4] = {cv0[0], cv0[2], cv1[0], cv1[2]}, ss[4] = {cv0[1], cv0[3], cv1[1], cv1[3]};
#pragma unroll
                for (int bj = 0; bj < 2; ++bj) { const int cg32 = u.pn * 8 + bj * 4 + wc; const int col = cg32 * 32 + 4 * fq;
                    f32x4 x1 = acc[ai][bj][m][0] * sc, x2 = acc[ai][bj][m][1] * sc;
                    if ((cg32 % 3) == 2) {
#pragma unroll
                        for (int j = 0; j < 4; ++j) { const float a = x1[j], b = x2[j]; x1[j] = a * cc[j] - b * ss[j]; x2[j] = a * ss[j] + b * cc[j]; }
                    }
                    u32x2 w0, w1; w0.x = cvtpk(x1[0], x1[1]); w0.y = cvtpk(x1[2], x1[3]); w1.x = cvtpk(x2[0], x2[1]); w1.y = cvtpk(x2[2], x2[3]);
                    bf16_t* p = O + (size_t)row * 768 + col; *(u32x2*)p = w0; *(u32x2*)(p + 16) = w1; } CFENCE(); }
    }
};
struct EpiGlu {
    static constexpr bool PERM = true;
    bf16_t* O; const bf16_t* z;
    DI void operator()(const Acc& acc, const Unit& u, int wr, int wc, int fr, int fq, LAS unsigned char*) const {
        const int row0 = u.pm * BM + wr * 64 + fr, col0 = u.pn * HALF + wc * 32 + 8 * fq;
#pragma unroll
        for (int ai = 0; ai < 2; ++ai)
#pragma unroll
            for (int m = 0; m < 4; ++m) { const int row = row0 + ai * HALF + m * 16;
                const u32x4 gz = *(const u32x4*)(z + (size_t)row * ZW + Z_GS + col0);
                const float gs[8] = {bflo(gz.x), bfhi(gz.x), bflo(gz.y), bfhi(gz.y), bflo(gz.z), bfhi(gz.z), bflo(gz.w), bfhi(gz.w)};
                float o[8];
#pragma unroll
                for (int n = 0; n < 2; ++n)
#pragma unroll
                    for (int j = 0; j < 4; ++j) o[4 * n + j] = acc[ai][0][m][n][j] * sigmoidf_(acc[ai][1][m][n][j]) * sigmoidf_(gs[4 * n + j]);
                u32x4 w; w.x = cvtpk(o[0], o[1]); w.y = cvtpk(o[2], o[3]); w.z = cvtpk(o[4], o[5]); w.w = cvtpk(o[6], o[7]);
                *(u32x4*)(O + (size_t)row * D + col0) = w; CFENCE(); }
    }
};
struct EpiOa {
    static constexpr bool PERM = true;
    bf16_t* O; const bf16_t* sg; const bf16_t* z;
    DI void operator()(const Acc& acc, const Unit& u, int wr, int wc, int fr, int fq, LAS unsigned char*) const {
        const int row0 = u.pm * BM + wr * 64 + fr, col0 = u.pn * BM + wc * 32 + 8 * fq;
#pragma unroll
        for (int ai = 0; ai < 2; ++ai)
#pragma unroll
            for (int m = 0; m < 4; ++m) { const int row = row0 + ai * HALF + m * 16;
#pragma unroll
                for (int bj = 0; bj < 2; ++bj) { const int col = col0 + bj * HALF;
                    const u32x4 gz = *(const u32x4*)(z + (size_t)row * ZW + Z_GA + col), sv = *(const u32x4*)(sg + (size_t)row * D + col);
                    const float ga[8] = {bflo(gz.x), bfhi(gz.x), bflo(gz.y), bfhi(gz.y), bflo(gz.z), bfhi(gz.z), bflo(gz.w), bfhi(gz.w)};
                    const float s8[8] = {bflo(sv.x), bfhi(sv.x), bflo(sv.y), bfhi(sv.y), bflo(sv.z), bfhi(sv.z), bflo(sv.w), bfhi(sv.w)};
                    float o[8];
#pragma unroll
                    for (int n = 0; n < 2; ++n)
#pragma unroll
                        for (int j = 0; j < 4; ++j) o[4 * n + j] = s8[4 * n + j] + sigmoidf_(ga[4 * n + j]) * acc[ai][bj][m][n][j];
                    u32x4 w; w.x = cvtpk(o[0], o[1]); w.y = cvtpk(o[2], o[3]); w.z = cvtpk(o[4], o[5]); w.w = cvtpk(o[6], o[7]);
                    *(u32x4*)(O + (size_t)row * D + col) = w; } CFENCE(); }
    }
};
struct EpiRes {
    static constexpr bool PERM = false;
    float* out; const float* src; const float* stats; const float* g; const float* b;
    DI void operator()(const Acc& acc, const Unit& u, int wr, int wc, int fr, int fq, LAS unsigned char*) const {
        const int col0 = u.pn * BM + wc * 32 + 4 * fq;
        f32x4 gv[2][2], bv[2][2];
#pragma unroll
        for (int bj = 0; bj < 2; ++bj)
#pragma unroll
            for (int n = 0; n < 2; ++n) { gv[bj][n] = *(const f32x4*)(g + col0 + bj * HALF + n * 16) * DN_ALPHA; bv[bj][n] = *(const f32x4*)(b + col0 + bj * HALF + n * 16) * DN_ALPHA; }
#pragma unroll
        for (int ai = 0; ai < 2; ++ai)
#pragma unroll
            for (int m = 0; m < 4; ++m) { const int row = u.pm * BM + ai * HALF + wr * 64 + m * 16 + fr; const size_t off = (size_t)row * D + col0;
                const f32x2 st = *(const f32x2*)(stats + (size_t)row * 2);
#pragma unroll
                for (int bj = 0; bj < 2; ++bj)
#pragma unroll
                    for (int n = 0; n < 2; ++n) { const f32x4 s = *(const f32x4*)(src + off + bj * HALF + n * 16);
                        const f32x4 o = (s - st.x) * st.y * gv[bj][n] + bv[bj][n] + acc[ai][bj][m][n];
                        *(f32x4*)(out + off + bj * HALF + n * 16) = o; } CFENCE(); }
    }
};
struct EpiSoftmax {
    static constexpr bool PERM = true;
    bf16_t* P; float* rs4;
    DI void operator()(const Acc& acc, const Unit& u, int wr, int wc, int fr, int fq, LAS unsigned char* lds) const {
        LAS float* X = (LAS float*)(lds + LDS_XCH);
        float mrow[2][4];
#pragma unroll
        for (int ai = 0; ai < 2; ++ai)
#pragma unroll
            for (int m = 0; m < 4; ++m) { float mx = -3.0e38f;
#pragma unroll
                for (int bj = 0; bj < 2; ++bj)
#pragma unroll
                    for (int n = 0; n < 2; ++n)
#pragma unroll
                        for (int j = 0; j < 4; ++j) mx = fmaxf(mx, acc[ai][bj][m][n][j]);
                mx = fmaxf(mx, __shfl_xor(mx, 16)); mx = fmaxf(mx, __shfl_xor(mx, 32));
                if (fq == 0) X[(ai * HALF + wr * 64 + m * 16 + fr) * 4 + wc] = mx; }
        asm volatile("s_waitcnt lgkmcnt(0)" ::: "memory"); __builtin_amdgcn_s_barrier(); asm volatile("" ::: "memory");
#pragma unroll
        for (int ai = 0; ai < 2; ++ai)
#pragma unroll
            for (int m = 0; m < 4; ++m) { const f32x4 v = *(const LAS f32x4*)(X + (ai * HALF + wr * 64 + m * 16 + fr) * 4); mrow[ai][m] = fmaxf(fmaxf(v[0], v[1]), fmaxf(v[2], v[3])); }
        const int row0 = u.pm * BM + wr * 64 + fr, col0 = u.pn * BM + wc * 32 + 8 * fq;
#pragma unroll
        for (int ai = 0; ai < 2; ++ai)
#pragma unroll
            for (int m = 0; m < 4; ++m) { const int row = row0 + ai * HALF + m * 16; float sum = 0.f; const float mr = mrow[ai][m];
#pragma unroll
                for (int bj = 0; bj < 2; ++bj) { float e[8];
#pragma unroll
                    for (int n = 0; n < 2; ++n)
#pragma unroll
                        for (int j = 0; j < 4; ++j) { e[4 * n + j] = __builtin_amdgcn_exp2f(acc[ai][bj][m][n][j] - mr); sum += e[4 * n + j]; }
                    u32x4 w; w.x = cvtpk(e[0], e[1]); w.y = cvtpk(e[2], e[3]); w.z = cvtpk(e[4], e[5]); w.w = cvtpk(e[6], e[7]);
                    *(u32x4*)(P + (size_t)row * D + col0 + bj * HALF) = w; }
                sum += __shfl_xor(sum, 16); sum += __shfl_xor(sum, 32);
                if (fq == 0) rs4[((size_t)row * 4 + u.pn) * 4 + wc] = sum; CFENCE(); }
        asm volatile("s_waitcnt lgkmcnt(0)" ::: "memory"); __builtin_amdgcn_s_barrier(); asm volatile("" ::: "memory");
    }
};
struct EpiPV {
    static constexpr bool PERM = true;
    bf16_t* O; const float* rs4;
    DI void operator()(const Acc& acc, const Unit& u, int wr, int wc, int fr, int fq, LAS unsigned char*) const {
        const int row0 = u.pm * BM + wr * 64 + fr, col0 = u.pn * BM + wc * 32 + 8 * fq;
#pragma unroll
        for (int ai = 0; ai < 2; ++ai)
#pragma unroll
            for (int m = 0; m < 4; ++m) { const int row = row0 + ai * HALF + m * 16; bf16_t* rowp = O + (size_t)row * D + col0;
                const f32x4 r4 = *(const f32x4*)(rs4 + ((size_t)row * 4 + u.pn) * 4); const float sc = 1.0f / ((r4[0] + r4[1]) + (r4[2] + r4[3]));
#pragma unroll
                for (int bj = 0; bj < 2; ++bj) { const f32x4 v0 = acc[ai][bj][m][0] * sc, v1 = acc[ai][bj][m][1] * sc;
                    u32x4 w; w.x = cvtpk(v0[0], v0[1]); w.y = cvtpk(v0[2], v0[3]); w.z = cvtpk(v1[0], v1[1]); w.w = cvtpk(v1[2], v1[3]);
                    *(u32x4*)(rowp + bj * HALF) = w; } CFENCE(); }
    }
};
}

struct Args { const void* in[33]; float* out; unsigned char* ws; int ph_lo, ph_hi, coop, pad; };
enum { I_X = 0, I_MEM, I_POS, I_LNING, I_LNINB, I_WIN, I_LAMRE, I_LAMIM, I_LOGDT, I_BRE, I_BIM, I_CRE, I_CIM, I_DSKIP, I_WGLU, I_QNG, I_WUQ, I_KVNG, I_WUKV,
       I_WOA, I_WO, I_LN1G, I_LN1B, I_WXQ, I_WXK, I_WXV, I_WXO, I_LN2G, I_LN2B, I_WUP, I_WDOWN, I_LN3G, I_LN3B };

template <int MODE>
DI void transpose_item(const float* W, int K, int N, bf16_t* WT, int row_off, const float* kscale, LAS float* scr, int item, int lane) {
    const int nblk = N / 32, kb = item / nblk, nb = item % nblk, k0 = 64 * kb, n0 = 32 * nb;
#pragma unroll 8
    for (int i = 0; i < 32; ++i) { const int kk = 2 * i + (lane >> 5); float v = W[(size_t)(k0 + kk) * N + n0 + (lane & 31)]; if (kscale) v *= kscale[k0 + kk]; scr[kk * 33 + (lane & 31)] = v; }
    LDS_WAIT();
    const int c = lane & 7;
#pragma unroll
    for (int j = 0; j < 4; ++j) { const int n = (lane >> 3) + 8 * j; const LAS float* s = scr + (8 * c) * 33 + n;
        u32x4 o; o.x = cvtpk(s[0 * 33], s[1 * 33]); o.y = cvtpk(s[2 * 33], s[3 * 33]); o.z = cvtpk(s[4 * 33], s[5 * 33]); o.w = cvtpk(s[6 * 33], s[7 * 33]);
        int nn = n0 + n, dst;
        if (MODE == 1) { const int half = nn >= 1024, n2 = nn & 1023; dst = 256 * (n2 >> 7) + 128 * half + (n2 & 127); } else dst = row_off + nn;
        *(u32x4*)(WT + (size_t)dst * K + k0 + 8 * c) = o; }
    LDS_WAIT();
}
DI void ln_row(const float* xrow, const float* g, const float* b, bf16_t* obf, float* of32, float* stat, int lane) {
    const f32x4* xr = (const f32x4*)xrow + lane;
    f32x4 v[4]; float s = 0.f;
#pragma unroll
    for (int j = 0; j < 4; ++j) { v[j] = xr[64 * j]; s += (v[j][0] + v[j][1]) + (v[j][2] + v[j][3]); }
    const float mean = wave_sum(s) * (1.f / D); float s2 = 0.f;
#pragma unroll
    for (int j = 0; j < 4; ++j) { v[j] = v[j] - mean; s2 += (v[j][0] * v[j][0] + v[j][1] * v[j][1]) + (v[j][2] * v[j][2] + v[j][3] * v[j][3]); }
    const float rstd = 1.0f / sqrtf(wave_sum(s2) * (1.f / D) + LN_EPS);
    if (stat && lane == 0) { stat[0] = mean; stat[1] = rstd; }
#pragma unroll
    for (int j = 0; j < 4; ++j) { const f32x4 gg = *((const f32x4*)g + lane + 64 * j), bb = *((const f32x4*)b + lane + 64 * j);
        const f32x4 o = v[j] * rstd * gg + bb;
        if (obf) { u32x2 w; w.x = cvtpk(o[0], o[1]); w.y = cvtpk(o[2], o[3]); *((u32x2*)obf + lane + 64 * j) = w; }
        if (of32) *((f32x4*)of32 + lane + 64 * j) = o; }
}

template <int PASS>
DI void s5_task(LAS unsigned char* lds, const unsigned char* ws, const float* dskip, int task, int wid, int lane) {
    const bf16_t* z = (const bf16_t*)(ws + WS_Z);
    float* E = (float*)(ws + WS_E);
    bf16_t* yg = (bf16_t*)(ws + WS_YG);
    const int chunk = task & (NCHUNK - 1), g = (task >> 4) & 15, b = task >> 8;
    const int r32 = lane & 31, hi = lane >> 5, fr = lane & 15, fq = lane >> 4;
    LAS float* sb = (LAS float*)(lds + wid * 16896);
    const float* s5t = (const float*)(ws + WS_S5T);
    const float ar = s5t[(g * 64 + lane) * 2], ai = s5t[(g * 64 + lane) * 2 + 1];
    bf16x8 bh[4], bl[4];
#pragma unroll
    for (int blk = 0; blk < 4; ++blk) { bh[blk] = *(const bf16x8*)(ws + WS_S5T + S5_BHI + ((size_t)(g * 128 + blk * 32 + r32) * 16 + 8 * hi) * 2);
                                        bl[blk] = *(const bf16x8*)(ws + WS_S5T + S5_BLO + ((size_t)(g * 128 + blk * 32 + r32) * 16 + 8 * hi) * 2); }
    bf16x8 ch[4], cl[4];
    float dsk = 0.f;
    if (PASS == 1) {
#pragma unroll
        for (int ks = 0; ks < 4; ++ks) { ch[ks] = *(const bf16x8*)(ws + WS_S5T + S5_CHI + ((size_t)(g * 16 + fr) * 128 + 32 * ks + 8 * fq) * 2);
                                         cl[ks] = *(const bf16x8*)(ws + WS_S5T + S5_CLO + ((size_t)(g * 16 + fr) * 128 + 32 * ks + 8 * fq) * 2); }
        dsk = dskip[g * 16 + fr];
    }
    float hr = 0.f, hi_ = 0.f;
    if (PASS == 1) {
        const float pr = s5t[S5_APOW / 4 + (g * 64 + lane) * 2], pi = s5t[S5_APOW / 4 + (g * 64 + lane) * 2 + 1];
        const float* Eb = E + ((size_t)(b * 16 + g) * NCHUNK) * 128;
        for (int j = 0; j < chunk; ++j) { const float er = Eb[j * 128 + lane], ei = Eb[j * 128 + 64 + lane];
            const float nr = pr * hr - pi * hi_ + er, ni = pr * hi_ + pi * hr + ei; hr = nr; hi_ = ni; }
    }
    const size_t row0 = (size_t)b * SEQ + (size_t)chunk * CHUNK;
    for (int blk32 = 0; blk32 < CHUNK / 32; ++blk32) {
        const size_t rb = row0 + blk32 * 32;
        const bf16x8 ua = *(const bf16x8*)(z + (rb + r32) * ZW + Z_U + g * 16 + 8 * hi);
#pragma unroll
        for (int blk = 0; blk < 4; ++blk) {
            f32x16 acc = {};
            acc = __builtin_amdgcn_mfma_f32_32x32x16_bf16(ua, bh[blk], acc, 0, 0, 0);
            acc = __builtin_amdgcn_mfma_f32_32x32x16_bf16(ua, bl[blk], acc, 0, 0, 0);
#pragma unroll
            for (int r = 0; r < 16; ++r) sb[crow(r, hi) * 132 + blk * 32 + r32] = acc[r];
        }
        LDS_WAIT();
#pragma unroll
        for (int t = 0; t < 32; ++t) { const float br = sb[t * 132 + lane], bi = sb[t * 132 + 64 + lane];
            const float nr = ar * hr - ai * hi_ + br, ni = ar * hi_ + ai * hr + bi; hr = nr; hi_ = ni;
            if (PASS == 1) { sb[t * 132 + lane] = hr; sb[t * 132 + 64 + lane] = hi_; } }
        if (PASS == 1) {
            LDS_WAIT();
#pragma unroll
            for (int th = 0; th < 2; ++th) {
                f32x4 y = {0.f, 0.f, 0.f, 0.f};
#pragma unroll
                for (int ks = 0; ks < 4; ++ks) {
                    const f32x4 h0 = *(const LAS f32x4*)(sb + (16 * th + fr) * 132 + 32 * ks + 8 * fq), h1 = *(const LAS f32x4*)(sb + (16 * th + fr) * 132 + 32 * ks + 8 * fq + 4);
                    u32x4 ph, pl;
                    ph.x = cvtpk(h0[0], h0[1]); ph.y = cvtpk(h0[2], h0[3]); ph.z = cvtpk(h1[0], h1[1]); ph.w = cvtpk(h1[2], h1[3]);
                    pl.x = cvtpk(h0[0] - bflo(ph.x), h0[1] - bfhi(ph.x)); pl.y = cvtpk(h0[2] - bflo(ph.y), h0[3] - bfhi(ph.y));
                    pl.z = cvtpk(h1[0] - bflo(ph.z), h1[1] - bfhi(ph.z)); pl.w = cvtpk(h1[2] - bflo(ph.w), h1[3] - bfhi(ph.w));
                    const bf16x8 ahi = __builtin_bit_cast(bf16x8, ph), alo = __builtin_bit_cast(bf16x8, pl);
                    y = __builtin_amdgcn_mfma_f32_16x16x32_bf16(ahi, ch[ks], y, 0, 0, 0);
                    y = __builtin_amdgcn_mfma_f32_16x16x32_bf16(alo, ch[ks], y, 0, 0, 0);
                    y = __builtin_amdgcn_mfma_f32_16x16x32_bf16(ahi, cl[ks], y, 0, 0, 0);
                }
#pragma unroll
                for (int r = 0; r < 4; ++r) { const size_t row = rb + 16 * th + 4 * fq + r;
                    const float uv = bf2f(z[row * ZW + Z_U + g * 16 + fr]);
                    const float yv = y[r] + dsk * uv;
                    const float ge = 0.5f * yv * (1.0f + erff(yv * 0.70710678118654752f));
                    yg[row * 256 + g * 16 + fr] = f2bf(ge); }
            }
            LDS_WAIT();
        }
    }
    if (PASS == 0) { float* Eo = E + ((size_t)(b * 16 + g) * NCHUNK + chunk) * 128; Eo[lane] = hr; Eo[64 + lane] = hi_; }
}

DI void attn_phase(LAS unsigned char* lds, const int wid, const bf16_t* Q, const bf16_t* KV, const bf16_t* KR, bf16_t* O) {
    const int lane = lane_id(), tid = wid * 64 + lane, r32 = lane & 31, hi = lane >> 5;
    constexpr int KROW = 208, VROW = 192, KBUF = 64 * KROW, VBUF = 64 * VROW, VOFF = 2 * KBUF;
    const int skey = tid >> 3, sc = tid & 7;
    const int vb0 = VOFF + (4 * hi + ((lane & 15) >> 2)) * VROW + ((lane >> 4) & 1) * 32 + (lane & 3) * 8;
    for (int it = blockIdx.x; it < 2048; it += gridDim.x) {
        const int r = it >> 8, wg = it & 255, bh = wg >> 2, j4 = wg & 3;
        const int qb = (r & 1) ? (4 * (r - 1) + 7 - j4) : (4 * r + j4);
        const int b = bh >> 3, h = bh & 7;
        const size_t rowbase = (size_t)b * SEQ; const int q0 = qb * 256;
        const int NT = 4 * (qb + 1);
        const int jlast = 4 * qb + (wid >> 1);
        const int qrel = 32 * (wid & 1) + r32;
        bf16x8 qr[6];
        { const bf16_t* qp = Q + (rowbase + q0 + wid * 32 + r32) * 768 + h * 96 + hi * 8;
#pragma unroll
          for (int d0 = 0; d0 < 6; ++d0) qr[d0] = *(const bf16x8*)(qp + d0 * 16); }
        const bf16_t* kvsrc = KV + (rowbase + skey) * 1024 + h * 128 + sc * 8;
        const bf16_t* krsrc = KR + (rowbase + (tid >> 2)) * 32 + (tid & 3) * 8;
        u32x4 sk, sv, sr = {0u, 0u, 0u, 0u};
        sk = *(const u32x4*)kvsrc; sv = *(const u32x4*)(kvsrc + 64); if (tid < 256) sr = *(const u32x4*)krsrc;
        float mrun = -1e30f, lrun = 0.f; f32x16 o0 = {}, o1 = {};
        for (int j = 0; j < NT; ++j) {
            const int buf = j & 1;
            *(LAS u32x4*)(lds + buf * KBUF + skey * KROW + sc * 16) = sk;
            *(LAS u32x4*)(lds + VOFF + buf * VBUF + skey * VROW + sc * 16) = sv;
            if (tid < 256) *(LAS u32x4*)(lds + buf * KBUF + (tid >> 2) * KROW + 128 + (tid & 3) * 16) = sr;
            __syncthreads();
            if (j + 1 < NT) { const size_t o = (size_t)(j + 1) * 64;
                sk = *(const u32x4*)(kvsrc + o * 1024); sv = *(const u32x4*)(kvsrc + o * 1024 + 64); if (tid < 256) sr = *(const u32x4*)(krsrc + o * 32); }
            if (j <= jlast) {
                const LAS unsigned char* kb = lds + buf * KBUF + r32 * KROW + hi * 16;
                f32x16 p0 = {}, p1 = {};
#pragma unroll
                for (int d0 = 0; d0 < 6; ++d0) {
                    const bf16x8 k0 = *(const LAS bf16x8*)(kb + d0 * 32), k1 = *(const LAS bf16x8*)(kb + 32 * KROW + d0 * 32);
                    p0 = __builtin_amdgcn_mfma_f32_32x32x16_bf16(k0, qr[d0], p0, 0, 0, 0);
                    p1 = __builtin_amdgcn_mfma_f32_32x32x16_bf16(k1, qr[d0], p1, 0, 0, 0);
                }
                if (j == jlast) {
#pragma unroll
                    for (int rr = 0; rr < 16; ++rr) { const int kv = crow(rr, hi); if (kv > qrel) p0[rr] = -1e30f; if (kv + 32 > qrel) p1[rr] = -1e30f; }
                }
                float mx = fmaxf(p0[0], p1[0]);
#pragma unroll
                for (int rr = 1; rr < 16; ++rr) mx = fmaxf(mx, fmaxf(p0[rr], p1[rr]));
                mx = fmaxf(mx, __shfl_xor(mx, 32));
                const float mnew = fmaxf(mrun, mx);
                const float alpha = __builtin_amdgcn_exp2f(mrun - mnew);
                float sum = 0.f;
#pragma unroll
                for (int rr = 0; rr < 16; ++rr) { p0[rr] = __builtin_amdgcn_exp2f(p0[rr] - mnew); p1[rr] = __builtin_amdgcn_exp2f(p1[rr] - mnew); sum += p0[rr] + p1[rr]; }
                lrun = lrun * alpha + sum; mrun = mnew;
                if (!__all(alpha == 1.0f)) { o0 = o0 * alpha; o1 = o1 * alpha; }
                bf16x8 pb[4];
#pragma unroll
                for (int s = 0; s < 2; ++s) { u32x4 w0, w1;
                    w0.x = cvtpk(p0[8 * s], p0[8 * s + 1]); w0.y = cvtpk(p0[8 * s + 2], p0[8 * s + 3]); w0.z = cvtpk(p0[8 * s + 4], p0[8 * s + 5]); w0.w = cvtpk(p0[8 * s + 6], p0[8 * s + 7]);
                    w1.x = cvtpk(p1[8 * s], p1[8 * s + 1]); w1.y = cvtpk(p1[8 * s + 2], p1[8 * s + 3]); w1.z = cvtpk(p1[8 * s + 4], p1[8 * s + 5]); w1.w = cvtpk(p1[8 * s + 6], p1[8 * s + 7]);
                    pb[s] = __builtin_bit_cast(bf16x8, w0); pb[2 + s] = __builtin_bit_cast(bf16x8, w1); }
                const LAS unsigned char* vb = lds + vb0 + buf * VBUF;
#pragma unroll
                for (int s = 0; s < 4; ++s) {
#pragma unroll
                    for (int d0 = 0; d0 < 2; ++d0) {
                        const s16x4 lo = __builtin_bit_cast(s16x4, __builtin_amdgcn_ds_read_tr16_b64_v4i16((LAS s16x4*)(vb + s * 16 * VROW + d0 * 64)));
                        const s16x4 hh = __builtin_bit_cast(s16x4, __builtin_amdgcn_ds_read_tr16_b64_v4i16((LAS s16x4*)(vb + s * 16 * VROW + 8 * VROW + d0 * 64)));
                        const bf16x8 vf = (bf16x8){lo[0], lo[1], lo[2], lo[3], hh[0], hh[1], hh[2], hh[3]};
                        if (d0 == 0) o0 = __builtin_amdgcn_mfma_f32_32x32x16_bf16(vf, pb[s], o0, 0, 0, 0);
                        else         o1 = __builtin_amdgcn_mfma_f32_32x32x16_bf16(vf, pb[s], o1, 0, 0, 0);
                    }
                }
            }
        }
        const float ltot = lrun + __shfl_xor(lrun, 32); const float inv = 1.0f / ltot;
        bf16_t* op = O + (rowbase + q0 + wid * 32 + r32) * 512 + h * 64 + 4 * hi;
#pragma unroll
        for (int gq = 0; gq < 4; ++gq) {
            u32x2 w0, w1;
            w0.x = cvtpk(o0[4 * gq] * inv, o0[4 * gq + 1] * inv); w0.y = cvtpk(o0[4 * gq + 2] * inv, o0[4 * gq + 3] * inv);
            w1.x = cvtpk(o1[4 * gq] * inv, o1[4 * gq + 1] * inv); w1.y = cvtpk(o1[4 * gq + 2] * inv, o1[4 * gq + 3] * inv);
            *(u32x2*)(op + 8 * gq) = w0; *(u32x2*)(op + 32 + 8 * gq) = w1;
        }
    }
}

__global__ void __launch_bounds__(NTHREADS, 2) fwd_kernel(Args a) {
    extern __shared__ __attribute__((aligned(16))) unsigned char lds_raw[];
    LAS unsigned char* lds = (LAS unsigned char*)lds_raw;
    const int wid = __builtin_amdgcn_readfirstlane(threadIdx.x >> 6);
    const int G = gridDim.x, bx = blockIdx.x;
    const int gw = bx * NWAVES + wid, NGW = G * NWAVES, NGT = G * NTHREADS;
#define IDS() const int lane = lane_id(); const int gt = bx * NTHREADS + wid * 64 + lane; (void)gt
    unsigned char* ws = a.ws;
    const int lo = a.ph_lo, hi = a.ph_hi;
#ifndef PHASE_MASK
#define PHASE_MASK 0xFFFFFFFFu
#endif
#define IN(k) (((PHASE_MASK >> (k)) & 1u) && lo <= (k) && (k) < hi)
#define SEAM(k) do { if (a.coop && IN(k) && IN((k) + 1)) grid_barrier((unsigned*)ws, (unsigned)((k) + 1) * (unsigned)G, wid); } while (0)
    if (a.coop) cg::this_grid().sync();
    const float* x = (const float*)a.in[I_X];
    bf16_t* z = (bf16_t*)(ws + WS_Z);

    if (IN(0)) {
        IDS();
        LAS float* scr = (LAS float*)(lds + wid * 16384);
        constexpr int IT_IN = (1024 / 64) * (2848 / 32), IT_GLU = (256 / 64) * (2048 / 32), IT_UQ = (256 / 64) * (768 / 32), IT_UKV = (256 / 64) * (1024 / 32), IT_OA = (512 / 64) * (1024 / 32),
                      IT_SQ = (1024 / 64) * (1024 / 32), IT_UP = (1024 / 64) * (4096 / 32), IT_DN = (4096 / 64) * (1024 / 32);
        constexpr int NITEMS = IT_IN + IT_GLU + IT_UQ + IT_UKV + IT_OA + 5 * IT_SQ + IT_UP + IT_DN;
        for (int it = gw; it < NITEMS; it += NGW) {
            int r = it;
            if (r < IT_IN) { transpose_item<0>((const float*)a.in[I_WIN], 1024, 2848, (bf16_t*)(ws + W_IN), 0, nullptr, scr, r, lane); continue; } r -= IT_IN;
            if (r < IT_GLU) { transpose_item<1>((const float*)a.in[I_WGLU], 256, 2048, (bf16_t*)(ws + W_GLU), 0, nullptr, scr, r, lane); continue; } r -= IT_GLU;
            if (r < IT_UQ) { transpose_item<0>((const float*)a.in[I_WUQ], 256, 768, (bf16_t*)(ws + W_UQ), 0, (const float*)a.in[I_QNG], scr, r, lane); continue; } r -= IT_UQ;
            if (r < IT_UKV) { transpose_item<0>((const float*)a.in[I_WUKV], 256, 1024, (bf16_t*)(ws + W_UKV), 0, (const float*)a.in[I_KVNG], scr, r, lane); continue; } r -= IT_UKV;
            if (r < IT_OA) { transpose_item<0>((const float*)a.in[I_WOA], 512, 1024, (bf16_t*)(ws + W_OA), 0, nullptr, scr, r, lane); continue; } r -= IT_OA;
            if (r < IT_SQ) { transpose_item<0>((const float*)a.in[I_WO], 1024, 1024, (bf16_t*)(ws + W_O), 0, nullptr, scr, r, lane); continue; } r -= IT_SQ;
            if (r < IT_SQ) { transpose_item<0>((const float*)a.in[I_WXQ], 1024, 1024, (bf16_t*)(ws + W_XQ), 0, nullptr, scr, r, lane); continue; } r -= IT_SQ;
            if (r < IT_SQ) { transpose_item<0>((const float*)a.in[I_WXK], 1024, 1024, (bf16_t*)(ws + W_XKV), 0, nullptr, scr, r, lane); continue; } r -= IT_SQ;
            if (r < IT_SQ) { transpose_item<0>((const float*)a.in[I_WXV], 1024, 1024, (bf16_t*)(ws + W_XKV), 1024, nullptr, scr, r, lane); continue; } r -= IT_SQ;
            if (r < IT_SQ) { transpose_item<0>((const float*)a.in[I_WXO], 1024, 1024, (bf16_t*)(ws + W_XO), 0, nullptr, scr, r, lane); continue; } r -= IT_SQ;
            if (r < IT_UP) { transpose_item<0>((const float*)a.in[I_WUP], 1024, 4096, (bf16_t*)(ws + W_UP), 0, nullptr, scr, r, lane); continue; } r -= IT_UP;
            transpose_item<0>((const float*)a.in[I_WDOWN], 4096, 1024, (bf16_t*)(ws + W_DOWN), 0, nullptr, scr, r, lane);
        }
        for (int i = gt; i < (3072 - 2848) * 1024 / 8; i += NGT) *((u32x4*)(ws + W_IN + (size_t)2848 * 1024 * 2) + i) = (u32x4){0u, 0u, 0u, 0u};
        for (int m = gw; m < T; m += NGW) ln_row(x + (size_t)m * D, (const float*)a.in[I_LNING], (const float*)a.in[I_LNINB], (bf16_t*)(ws + WS_HN) + (size_t)m * D, nullptr, (float*)(ws + WS_STAT0) + (size_t)m * 2, lane);
        { const float* mem = (const float*)a.in[I_MEM]; bf16_t* mb = (bf16_t*)(ws + WS_MEMB);
          for (int i = gt; i < BATCH * MEMT * D / 4; i += NGT) { const f32x4 v = *((const f32x4*)mem + i); u32x2 w; w.x = cvtpk(v[0], v[1]); w.y = cvtpk(v[2], v[3]); *((u32x2*)mb + i) = w; } }
        { const int* pos = (const int*)a.in[I_POS]; float* cs = (float*)(ws + WS_CS);
          for (int i = gt; i < T * 16; i += NGT) { const int row = i >> 4, k = i & 15;
              const float inv = exp2f(-(float)k * (13.287712379549449f / 16.0f));
              const float ang = (float)pos[row] * inv; double s, c; sincos_d((double)ang, s, c);
              *(f32x2*)(cs + (size_t)i * 2) = (f32x2){(float)c, (float)s}; } }
        if (gt < 16 * 64) {
            const int g = gt >> 6, p = gt & 63;
            const float lrf = fminf(((const float*)a.in[I_LAMRE])[gt], -1e-4f), lif = ((const float*)a.in[I_LAMIM])[gt];
            const double lr = lrf, li = lif, dt = exp_d((double)((const float*)a.in[I_LOGDT])[g]);
            const double mag = exp_d(lr * dt); double sn, cn; sincos_d(li * dt, sn, cn);
            const double abr = mag * cn, abi = mag * sn;
            float* s5t = (float*)(ws + WS_S5T);
            s5t[gt * 2] = (float)abr; s5t[gt * 2 + 1] = (float)abi;
            double pr = abr, pi = abi;
            for (int i = 0; i < 9; ++i) { const double nr = pr * pr - pi * pi, ni = 2.0 * pr * pi; pr = nr; pi = ni; }
            s5t[S5_APOW / 4 + gt * 2] = (float)pr; s5t[S5_APOW / 4 + gt * 2 + 1] = (float)pi;
            const double den = lr * lr + li * li, nrr = abr - 1.0;
            const double fre = (nrr * lr + abi * li) / den, fim = (abi * lr - nrr * li) / den;
            bf16_t* BH = (bf16_t*)(ws + WS_S5T + S5_BHI); bf16_t* BL = (bf16_t*)(ws + WS_S5T + S5_BLO);
            bf16_t* CH = (bf16_t*)(ws + WS_S5T + S5_CHI); bf16_t* CL = (bf16_t*)(ws + WS_S5T + S5_CLO);
            for (int c = 0; c < 16; ++c) {
                const double br = ((const float*)a.in[I_BRE])[gt * 16 + c], bi = ((const float*)a.in[I_BIM])[gt * 16 + c];
                const float bbr = (float)(fre * br - fim * bi), bbi = (float)(fre * bi + fim * br);
                const bf16_t h0 = f2bf(bbr), h1 = f2bf(bbi);
                BH[(g * 128 + p) * 16 + c] = h0; BL[(g * 128 + p) * 16 + c] = f2bf(bbr - bf2f(h0));
                BH[(g * 128 + 64 + p) * 16 + c] = h1; BL[(g * 128 + 64 + p) * 16 + c] = f2bf(bbi - bf2f(h1));
                const float cr = ((const float*)a.in[I_CRE])[(g * 16 + c) * 64 + p], ci = -((const float*)a.in[I_CIM])[(g * 16 + c) * 64 + p];
                const bf16_t c0 = f2bf(cr), c1 = f2bf(ci);
                CH[(g * 16 + c) * 128 + p] = c0; CL[(g * 16 + c) * 128 + p] = f2bf(cr - bf2f(c0));
                CH[(g * 16 + c) * 128 + 64 + p] = c1; CL[(g * 16 + c) * 128 + 64 + p] = f2bf(ci - bf2f(c1));
            }
        }
        __syncthreads();
    }
    SEAM(0);

    if (IN(1)) {
        { pg8::Gemm g{(const bf16_t*)(ws + WS_HN), (const bf16_t*)(ws + W_IN), 1024, 1024, 1024}; pg8::StdOrder S; S.init(T, ZW, 1024, 1024, G, bx);
          pg8::EpiStore E{z, ZW, 1.0f, nullptr, 0};
          pg8::gemm_phase<pg8::EpiStore, pg8::StdOrder, true>(lds, wid, g, S, E); }
        { pg8::Gemm g{(const bf16_t*)(ws + WS_MEMB), (const bf16_t*)(ws + W_XKV), 1024, 1024, 1024}; pg8::StdOrder S; S.init(BATCH * MEMT, 2048, 1024, 1024, G, bx);
          pg8::EpiStore E{(bf16_t*)(ws + WS_KVX), 2048, 1.0f, nullptr, 0};
          pg8::gemm_phase<pg8::EpiStore, pg8::StdOrder, true>(lds, wid, g, S, E); }
    }
    SEAM(1);

    if (IN(2)) {
        IDS();
        { float* rms = (float*)(ws + WS_RMS); const float* cs = (const float*)(ws + WS_CS); bf16_t* kr = (bf16_t*)(ws + WS_KR);
          for (int m = gw; m < T; m += NGW) {
              const bf16_t* zr = z + (size_t)m * ZW;
              const u32x4 v = *(const u32x4*)(zr + Z_CQ + 8 * lane);
              const float e[8] = {bflo(v.x), bfhi(v.x), bflo(v.y), bfhi(v.y), bflo(v.z), bfhi(v.z), bflo(v.w), bfhi(v.w)};
              float s = 0.f;
#pragma unroll
              for (int j = 0; j < 8; ++j) s += e[j] * e[j];
#pragma unroll
              for (int o = 1; o < 32; o <<= 1) s += __shfl_xor(s, o);
              if ((lane & 31) == 0) rms[(size_t)m * 2 + (lane >> 5)] = 1.0f / sqrtf(s * (1.0f / 256.0f) + RMS_EPS);
              if (lane < 16) { const float x1 = bf2f(zr[Z_KR + lane]), x2 = bf2f(zr[Z_KR + 16 + lane]); const f32x2 c2 = *(const f32x2*)(cs + ((size_t)m * 16 + lane) * 2);
                  kr[(size_t)m * 32 + lane] = f2bf(x1 * c2.x - x2 * c2.y); kr[(size_t)m * 32 + 16 + lane] = f2bf(x1 * c2.y + x2 * c2.x); }
          } }
        { const bf16_t* kvx = (const bf16_t*)(ws + WS_KVX); bf16_t* vxt = (bf16_t*)(ws + WS_VXT);
          for (int i = gt; i < BATCH * 4 * 256 * 256; i += NGT) { const int key = i & 255, dim = (i >> 8) & 255, h = (i >> 16) & 3, b = i >> 18;
              vxt[i] = kvx[(size_t)(b * 256 + key) * 2048 + 1024 + h * 256 + dim]; } }
        for (int task = gw; task < BATCH * 16 * NCHUNK; task += NGW) s5_task<0>(lds, ws, nullptr, task, wid, lane);
        __syncthreads();
    }
    SEAM(2);

    if (IN(3)) {
        IDS();
        for (int task = gw; task < BATCH * 16 * NCHUNK; task += NGW) s5_task<1>(lds, ws, (const float*)a.in[I_DSKIP], task, wid, lane);
        __syncthreads();
    }
    SEAM(3);

    if (IN(4)) {
#ifndef P4SEL
#define P4SEL 7
#endif
        if (P4SEL & 1) { pg8::Gemm g{z + Z_CQ, (const bf16_t*)(ws + W_UQ), ZW, 256, 256}; pg8::StdOrder S; S.init(T, 768, ZW, 256, G, bx);
          pg8::EpiQ E{(bf16_t*)(ws + WS_Q), (const float*)(ws + WS_RMS), (const float*)(ws + WS_CS), 0.10206207261596577f * LOG2E};
          pg8::gemm_phase<pg8::EpiQ, pg8::StdOrder, true>(lds, wid, g, S, E); }
        if (P4SEL & 2) { pg8::Gemm g{z + Z_CKV, (const bf16_t*)(ws + W_UKV), ZW, 256, 256}; pg8::StdOrder S; S.init(T, 1024, ZW, 256, G, bx);
          pg8::EpiStore E{(bf16_t*)(ws + WS_KV), 1024, 1.0f, (const float*)(ws + WS_RMS) + 1, 2};
          pg8::gemm_phase<pg8::EpiStore, pg8::StdOrder, true>(lds, wid, g, S, E); }
        if (P4SEL & 4) { pg8::Gemm g{(const bf16_t*)(ws + WS_YG), (const bf16_t*)(ws + W_GLU), 256, 256, 256}; pg8::StdOrder S; S.init(T, 2048, 256, 256, G, bx);
          pg8::EpiGlu E{(bf16_t*)(ws + WS_SG), z};
          pg8::gemm_phase<pg8::EpiGlu, pg8::StdOrder, true>(lds, wid, g, S, E); }
    }
    SEAM(4);

    if (IN(5)) {
        attn_phase(lds, wid, (const bf16_t*)(ws + WS_Q), (const bf16_t*)(ws + WS_KV), (const bf16_t*)(ws + WS_KR), (bf16_t*)(ws + WS_ATT));
        __syncthreads();
    }
    SEAM(5);

    if (IN(6)) {
        pg8::Gemm g{(const bf16_t*)(ws + WS_ATT), (const bf16_t*)(ws + W_OA), 512, 512, 512}; pg8::StdOrder S; S.init(T, 1024, 512, 512, G, bx);
        pg8::EpiOa E{(bf16_t*)(ws + WS_GATED), (const bf16_t*)(ws + WS_SG), z};
        pg8::gemm_phase<pg8::EpiOa, pg8::StdOrder, true>(lds, wid, g, S, E);
    }
    SEAM(6);

    if (IN(7)) {
        pg8::Gemm g{(const bf16_t*)(ws + WS_GATED), (const bf16_t*)(ws + W_O), 1024, 1024, 1024}; pg8::StdOrder S; S.init(T, 1024, 1024, 1024, G, bx);
        pg8::EpiRes E{(float*)(ws + WS_R1), x, (const float*)(ws + WS_STAT0), (const float*)a.in[I_LNING], (const float*)a.in[I_LNINB]};
        pg8::gemm_phase<pg8::EpiRes, pg8::StdOrder, true>(lds, wid, g, S, E);
    }
    SEAM(7);

    if (IN(8)) {
        IDS();
        for (int m = gw; m < T; m += NGW) ln_row((const float*)(ws + WS_R1) + (size_t)m * D, (const float*)a.in[I_LN1G], (const float*)a.in[I_LN1B], (bf16_t*)(ws + WS_H1B) + (size_t)m * D, nullptr, (float*)(ws + WS_STAT1) + (size_t)m * 2, lane);
    }
    SEAM(8);

    if (IN(9)) {
        pg8::Gemm g{(const bf16_t*)(ws + WS_H1B), (const bf16_t*)(ws + W_XQ), 1024, 1024, 1024}; pg8::StdOrder S; S.init(T, 1024, 1024, 1024, G, bx);
        pg8::EpiStore E{(bf16_t*)(ws + WS_XQ), 1024, 0.0625f * LOG2E, nullptr, 0};
        pg8::gemm_phase<pg8::EpiStore, pg8::StdOrder, true>(lds, wid, g, S, E);
    }
    SEAM(9);

    if (IN(10)) {
        pg8::Gemm g{(const bf16_t*)(ws + WS_XQ), (const bf16_t*)(ws + WS_KVX), 1024, 2048, 256}; pg8::XattnOrder S{G, bx, 1024, (long)256 * 2048, 256};
        pg8::EpiSoftmax E{(bf16_t*)(ws + WS_P), (float*)(ws + WS_RS4)};
        pg8::gemm_phase<pg8::EpiSoftmax, pg8::XattnOrder, true>(lds, wid, g, S, E);
    }
    SEAM(10);

    if (IN(11)) {
        pg8::Gemm g{(const bf16_t*)(ws + WS_P), (const bf16_t*)(ws + WS_VXT), 1024, 256, 256}; pg8::XattnOrder S{G, bx, 1024, (long)4 * 65536, 65536};
        pg8::EpiPV E{(bf16_t*)(ws + WS_XOIN), (const float*)(ws + WS_RS4)};
        pg8::gemm_phase<pg8::EpiPV, pg8::XattnOrder, true>(lds, wid, g, S, E);
    }
    SEAM(11);

    if (IN(12)) {
        pg8::Gemm g{(const bf16_t*)(ws + WS_XOIN), (const bf16_t*)(ws + W_XO), 1024, 1024, 1024}; pg8::StdOrder S; S.init(T, 1024, 1024, 1024, G, bx);
        pg8::EpiRes E{(float*)(ws + WS_R2), (const float*)(ws + WS_R1), (const float*)(ws + WS_STAT1), (const float*)a.in[I_LN1G], (const float*)a.in[I_LN1B]};
        pg8::gemm_phase<pg8::EpiRes, pg8::StdOrder, true>(lds, wid, g, S, E);
    }
    SEAM(12);

    if (IN(13)) {
        IDS();
        for (int m = gw; m < T; m += NGW) ln_row((const float*)(ws + WS_R2) + (size_t)m * D, (const float*)a.in[I_LN2G], (const float*)a.in[I_LN2B], (bf16_t*)(ws + WS_H2B) + (size_t)m * D, nullptr, (float*)(ws + WS_STAT2) + (size_t)m * 2, lane);
    }
    SEAM(13);

    if (IN(14)) {
        pg8::Gemm g{(const bf16_t*)(ws + WS_H2B), (const bf16_t*)(ws + W_UP), 1024, 1024, 1024}; pg8::StdOrder S; S.init(T, 4096, 1024, 1024, G, bx);
        pg8::EpiRelu2 E{(bf16_t*)(ws + WS_HID), 4096};
        pg8::gemm_phase<pg8::EpiRelu2, pg8::StdOrder, true>(lds, wid, g, S, E);
    }
    SEAM(14);

    if (IN(15)) {
        pg8::Gemm g{(const bf16_t*)(ws + WS_HID), (const bf16_t*)(ws + W_DOWN), 4096, 4096, 4096}; pg8::StdOrder S; S.init(T, 1024, 4096, 4096, G, bx);
        pg8::EpiRes E{a.out, (const float*)(ws + WS_R2), (const float*)(ws + WS_STAT2), (const float*)a.in[I_LN2G], (const float*)a.in[I_LN2B]};
        pg8::gemm_phase<pg8::EpiRes, pg8::StdOrder, true>(lds, wid, g, S, E);
    }
    SEAM(15);

    if (IN(16)) {
        IDS();
        for (int m = gw; m < T; m += NGW) ln_row(a.out + (size_t)m * D, (const float*)a.in[I_LN3G], (const float*)a.in[I_LN3B], nullptr, a.out + (size_t)m * D, nullptr, lane);
    }
#undef IN
#undef SEAM
}

constexpr int NPHASES = 17;
#ifndef N_LAUNCH_MODE
#define N_LAUNCH_MODE 1
#endif

extern "C" void kernel_launch(void* const* d_in, const int* in_sizes, int n_in, void* d_out, int out_size, void* d_ws, size_t ws_size, hipStream_t stream) {
    static int grid = 0;
    if (grid == 0) {
        if (n_in != 33 || out_size != T * D || ws_size < WS_END) { fprintf(stderr, "kernel_launch: unexpected problem (n_in %d, out %d, ws %zu)\n", n_in, out_size, ws_size); grid = -1; return; }
        int dev = 0, cus = 0, per_cu = 0;
        (void)hipGetDevice(&dev); (void)hipDeviceGetAttribute(&cus, hipDeviceAttributeMultiprocessorCount, dev);
        if (hipFuncSetAttribute((const void*)fwd_kernel, hipFuncAttributeMaxDynamicSharedMemorySize, LDS_BYTES) != hipSuccess) { fprintf(stderr, "kernel_launch: hipFuncSetAttribute failed\n"); grid = -1; return; }
        if (hipOccupancyMaxActiveBlocksPerMultiprocessor(&per_cu, (const void*)fwd_kernel, NTHREADS, LDS_BYTES) != hipSuccess || per_cu < 1) { fprintf(stderr, "kernel_launch: occupancy query gave %d\n", per_cu); per_cu = 1; }
        (void)hipGetLastError();
        grid = cus;
        fprintf(stderr, "kernel_launch: grid %d (occupancy query %d per CU)\n", grid, per_cu);
    }
    if (grid < 0) return;
    if (hipMemsetAsync(d_ws, 0, 256, stream) != hipSuccess) { fprintf(stderr, "kernel_launch: memset failed\n"); return; }
    Args a{};
    for (int i = 0; i < 33; ++i) a.in[i] = d_in[i];
    a.out = (float*)d_out; a.ws = (unsigned char*)d_ws;
#if N_LAUNCH_MODE == 0
    a.ph_lo = 0; a.ph_hi = NPHASES; a.coop = 1;
    void* args[] = {&a};
    hipError_t e = hipLaunchCooperativeKernel((const void*)fwd_kernel, dim3(grid), dim3(NTHREADS), args, LDS_BYTES, stream);
    if (e != hipSuccess) fprintf(stderr, "kernel_launch: cooperative launch failed: %s\n", hipGetErrorString(e));
#else
    for (int p = 0; p < NPHASES; ++p) { a.ph_lo = p; a.ph_hi = p + 1; a.coop = 0;
        hipLaunchKernelGGL(fwd_kernel, dim3(grid), dim3(NTHREADS), LDS_BYTES, stream, a); }
#endif
}
```

```cpp
#include <hip/hip_runtime.h>
#include <hip/hip_cooperative_groups.h>
#include <cstdio>
#include <cstdint>
namespace cg = cooperative_groups;

#define LAS __attribute__((address_space(3)))
#define DI __device__ __forceinline__
typedef unsigned short bf16_t;
typedef short bf16x8 __attribute__((ext_vector_type(8)));
typedef short s16x4 __attribute__((ext_vector_type(4)));
typedef float f32x2 __attribute__((ext_vector_type(2)));
typedef float f32x4 __attribute__((ext_vector_type(4)));
typedef float f32x16 __attribute__((ext_vector_type(16)));
typedef unsigned u32x2 __attribute__((ext_vector_type(2)));
typedef unsigned u32x4 __attribute__((ext_vector_type(4)));
typedef __bf16 bf16x2_t __attribute__((ext_vector_type(2)));

constexpr int BATCH = 8, SEQ = 8192, T = BATCH * SEQ, D = 1024;
constexpr int ZW = 3072;
constexpr int Z_U = 0, Z_CQ = 256, Z_CKV = 512, Z_KR = 768, Z_GS = 800, Z_GA = 1824;
constexpr int MEMT = 256;
constexpr int NCHUNK = 16, CHUNK = SEQ / NCHUNK;
constexpr float LN_EPS = 1e-5f, RMS_EPS = 1e-6f;
constexpr float DN_ALPHA = 1.189207115002721f;
constexpr float LOG2E = 1.4426950408889634f;
constexpr int NTHREADS = 512, NWAVES = 8;
constexpr int LDS_BYTES = 147456;
constexpr int LDS_XCH = 131072;

constexpr size_t MiB = 1ull << 20;
constexpr size_t WS_STAT0 = 1 * MiB, WS_RMS = 1 * MiB + 512 * 1024, WS_STAT1 = 2 * MiB, WS_STAT2 = 2 * MiB + 512 * 1024;
constexpr size_t WS_RS4 = 3 * MiB;
constexpr size_t WS_E = 7 * MiB;
constexpr size_t WS_CS = 8 * MiB;
constexpr size_t WS_KR = 16 * MiB;
constexpr size_t WS_MEMB = 20 * MiB;
constexpr size_t WS_KVX = 24 * MiB;
constexpr size_t WS_VXT = 32 * MiB;
constexpr size_t WS_S5T = 36 * MiB;
constexpr size_t WS_W = 40 * MiB;
constexpr size_t W_IN = WS_W, W_GLU = W_IN + 6 * MiB, W_UQ = W_GLU + 1 * MiB, W_UKV = W_UQ + 512 * 1024, W_OA = W_UKV + 512 * 1024,
                 W_O = W_OA + 1 * MiB, W_XQ = W_O + 2 * MiB, W_XKV = W_XQ + 2 * MiB, W_XO = W_XKV + 4 * MiB, W_UP = W_XO + 2 * MiB, W_DOWN = W_UP + 8 * MiB;
static_assert(W_DOWN + 8 * MiB <= 80 * MiB, "weights");
constexpr size_t WS_Z = 80 * MiB;
constexpr size_t WS_HN = 464 * MiB;
constexpr size_t WS_SG = 464 * MiB;
constexpr size_t WS_Q = 592 * MiB;
constexpr size_t WS_KV = 688 * MiB;
constexpr size_t WS_YG = 816 * MiB;
constexpr size_t WS_ATT = 848 * MiB;
constexpr size_t WS_GATED = 592 * MiB;
constexpr size_t WS_R1 = 80 * MiB;
constexpr size_t WS_H1B = 336 * MiB;
constexpr size_t WS_XQ = 464 * MiB;
constexpr size_t WS_P = 592 * MiB;
constexpr size_t WS_XOIN = 336 * MiB;
constexpr size_t WS_R2 = 720 * MiB;
constexpr size_t WS_H2B = 592 * MiB;
constexpr size_t WS_HID = 80 * MiB;
constexpr size_t WS_END = 1024 * MiB;

constexpr size_t S5_ABAR = 0;
constexpr size_t S5_APOW = 8192;
constexpr size_t S5_BHI = 16384;
constexpr size_t S5_BLO = S5_BHI + 65536;
constexpr size_t S5_CHI = S5_BLO + 65536;
constexpr size_t S5_CLO = S5_CHI + 65536;

DI unsigned cvtpk(float lo, float hi) { f32x2 v = {lo, hi}; bf16x2_t b = __builtin_convertvector(v, bf16x2_t); return __builtin_bit_cast(unsigned, b); }
DI float bf2f(unsigned short u) { return __uint_as_float((unsigned)u << 16); }
DI float bflo(unsigned u) { return __uint_as_float(u << 16); }
DI float bfhi(unsigned u) { return __uint_as_float(u & 0xffff0000u); }
DI bf16_t f2bf(float f) { return (bf16_t)(cvtpk(f, 0.f) & 0xffffu); }
DI float sigmoidf_(float x) { return 1.0f / (1.0f + __expf(-x)); }
DI int crow(int r, int hi) { return (r & 3) + 8 * (r >> 2) + 4 * hi; }
DI float wave_sum(float v) {
#pragma unroll
    for (int o = 1; o < 64; o <<= 1) v += __shfl_xor(v, o);
    return v;
}
#define LDS_WAIT() asm volatile("s_waitcnt lgkmcnt(0)" ::: "memory")
#define CFENCE() asm volatile("" ::: "memory")
DI int lane_id() { int l; asm volatile("v_mbcnt_lo_u32_b32 %0, -1, 0\n\tv_mbcnt_hi_u32_b32 %0, -1, %0" : "=v"(l)); return l; }
DI void sincos_d(double x, double& s, double& c) {
    const double TWO_PI = 6.283185307179586476925287;
    const double k = rint(x / TWO_PI); const double r = x - k * TWO_PI;
    const double q = r * 0.25, q2 = q * q;
    double ss = q * (1.0 - q2 / 6.0 * (1.0 - q2 / 20.0 * (1.0 - q2 / 42.0 * (1.0 - q2 / 72.0 * (1.0 - q2 / 110.0 * (1.0 - q2 / 156.0 * (1.0 - q2 / 210.0)))))));
    double cc = 1.0 - q2 / 2.0 * (1.0 - q2 / 12.0 * (1.0 - q2 / 30.0 * (1.0 - q2 / 56.0 * (1.0 - q2 / 90.0 * (1.0 - q2 / 132.0 * (1.0 - q2 / 182.0))))));
    const double s2 = 2.0 * ss * cc, c2 = 1.0 - 2.0 * ss * ss;
    s = 2.0 * s2 * c2; c = 1.0 - 2.0 * s2 * s2;
}
DI double exp_d(double x) {
    const double LN2 = 0.693147180559945309417232;
    const double k = rint(x / LN2); const double r = x - k * LN2;
    double p = 1.0;
#pragma unroll
    for (int i = 16; i >= 1; --i) p = 1.0 + p * r / (double)i;
    const long long e = (long long)k + 1023; const double sc = __longlong_as_double(e << 52);
    return p * sc;
}

DI void grid_barrier(unsigned* ctr, unsigned target, int wid) {
    asm volatile("s_waitcnt vmcnt(0) lgkmcnt(0)" ::: "memory");
    __syncthreads();
    if (wid == 0) {
        const int lane = lane_id();
        if (lane == 0) {
            __builtin_amdgcn_fence(__ATOMIC_RELEASE, "agent");
            asm volatile("s_waitcnt vmcnt(0)" ::: "memory");
            __hip_atomic_fetch_add(ctr, 1u, __ATOMIC_RELAXED, __HIP_MEMORY_SCOPE_AGENT);
            while (__hip_atomic_load(ctr, __ATOMIC_RELAXED, __HIP_MEMORY_SCOPE_AGENT) < target) __builtin_amdgcn_s_sleep(4);
            __builtin_amdgcn_fence(__ATOMIC_ACQUIRE, "agent");
            asm volatile("s_waitcnt vmcnt(0)" ::: "memory");
        }
    }
    __syncthreads();
}

namespace pg8 {
constexpr int BM = 256, BK = 64, HALF = 128, HTB = HALF * BK * 2, STAGE_BYTES = 8 * HTB, NXCD = 8, WGM = 8;
DI int lds_byte(int r, int c) { const int st = (r >> 4) * 2 + (c >> 5), rr = r & 15, cc = c & 31, ob = rr * 64 + cc * 2; return st * 1024 + (ob ^ (((ob >> 9) & 1) << 5)); }
DI void stage_rc(int b, int& R, int& C) { const int st = b / 1024, sb = b % 1024, swz = sb ^ (((sb >> 9) & 1) << 5); R = (st >> 1) * 16 + swz / 64; C = (st & 1) * 32 + (swz % 64) / 2; }
DI int perm32(int rho) { const int n = rho >> 4, i = rho & 15; return 8 * (i >> 2) + 4 * n + (i & 3); }

struct Unit { int pm, pn; long ao, bo; };
struct Gemm { const bf16_t* A; const bf16_t* Bt; int lda, ldb, K; };

struct StdOrder {
    int nM, nN, nwg, G, c, lda, ldb;
    DI void init(int M, int N, int lda_, int ldb_, int G_, int c_) { nM = M / BM; nN = N / BM; nwg = nM * nN; G = G_; c = c_; lda = lda_; ldb = ldb_; }
    DI bool next(int i, Unit& u) const {
        const long L = (long)i * G + c; if (L >= nwg) return false;
        int wgid = (int)L; { const int q = nwg / NXCD, r = nwg % NXCD, xcd = wgid % NXCD, off = wgid / NXCD; wgid = (xcd < r ? xcd * (q + 1) : r * (q + 1) + (xcd - r) * q) + off; }
        const int nig = WGM * nN, gid = wgid / nig, fm = gid * WGM, gsz = (nM - fm) < WGM ? (nM - fm) : WGM;
        u.pm = fm + ((wgid % nig) % gsz); u.pn = (wgid % nig) / gsz;
        u.ao = (long)u.pm * BM * lda; u.bo = (long)u.pn * BM * ldb; return true;
    }
};
struct XattnOrder {
    int G, c, lda; long bstride_b, bstride_h;
    DI bool next(int i, Unit& u) const {
        const long L = (long)i * G + c; if (L >= 1024) return false;
        const int bh = (int)L >> 5, pml = (int)L & 31, b = bh >> 2, h = bh & 3;
        u.pm = b * 32 + pml; u.pn = h;
        u.ao = (long)u.pm * BM * lda + h * 256; u.bo = (long)b * bstride_b + (long)h * bstride_h; return true;
    }
};

typedef f32x4 Acc[2][2][4][2];

template <class Epi, class Sched, bool ALIGN_EPI>
DI void gemm_phase(LAS unsigned char* lds, const int wid, const Gemm g, const Sched& S, const Epi& E) {
    const int lane = lane_id(), tid = wid * 64 + lane, wr = wid >> 2, wc = wid & 3, fr = lane & 15, fq = lane >> 4;
    const int K = g.K, nt = K / BK;
    unsigned voffA[2], voffB[2];
#pragma unroll
    for (int i = 0; i < 2; ++i) { int R, C; stage_rc(tid * 16 + i * 8192, R, C); const int Rb = Epi::PERM ? ((R & ~31) + perm32(R & 31)) : R;
        voffA[i] = (unsigned)(R * g.lda + C) * 2u; voffB[i] = (unsigned)(Rb * g.ldb + C) * 2u; }
    const size_t kstep = (size_t)(BK * 2);
    const size_t hstepA = (size_t)HALF * g.lda * 2, hstepB = (size_t)HALF * g.ldb * 2;
    const unsigned ldsw = (unsigned)wid * 1024u;
    const int aoff = lds_byte(wr * 64 + fr, fq * 8), boff = lds_byte(wc * 32 + fr, fq * 8);
#define PG8_SA(b, h) (((b) * 2 + (h)) * HTB)
#define PG8_SB(b, h) ((4 + (b) * 2 + (h)) * HTB)
#define PG8_STAGE(bufoff, gbase, voff) do { _Pragma("unroll") for (int _i = 0; _i < 2; ++_i) \
        __builtin_amdgcn_global_load_lds((const unsigned*)((const char*)(gbase) + (voff)[_i]), (LAS unsigned*)(lds + (bufoff) + ldsw + _i * 8192), 16, 0, 0); } while (0)
#define PG8_LDA(dst, b, h) do { _Pragma("unroll") for (int m = 0; m < 4; ++m) _Pragma("unroll") for (int k = 0; k < 2; ++k) dst[m][k] = *(const LAS bf16x8*)(lds + PG8_SA(b, h) + aoff + m * 2048 + k * 1024); } while (0)
#define PG8_LDB(dst, b, h) do { _Pragma("unroll") for (int n = 0; n < 2; ++n) _Pragma("unroll") for (int k = 0; k < 2; ++k) dst[n][k] = *(const LAS bf16x8*)(lds + PG8_SB(b, h) + boff + n * 2048 + k * 1024); } while (0)
#define PG8_MMA(ai, bj, At, Bt) do { __builtin_amdgcn_s_setprio(1); _Pragma("unroll") for (int m = 0; m < 4; ++m) _Pragma("unroll") for (int n = 0; n < 2; ++n) _Pragma("unroll") for (int k = 0; k < 2; ++k) \
        acc[ai][bj][m][n] = __builtin_amdgcn_mfma_f32_16x16x32_bf16(Bt[n][k], At[m][k], acc[ai][bj][m][n], 0, 0, 0); __builtin_amdgcn_s_setprio(0); } while (0)
#define PG8_WAIT_V(n) asm volatile("s_waitcnt vmcnt(" #n ")" ::: "memory")
#define PG8_WAIT_L(n) asm volatile("s_waitcnt lgkmcnt(" #n ")" ::: "memory")
#define PG8_BAR __builtin_amdgcn_s_barrier()
#define PG8_SCHED __builtin_amdgcn_sched_barrier(0)
    Unit cur, nxt; int ui = 0;
    if (!S.next(0, cur)) return;
    Acc acc;
#pragma unroll
    for (int a = 0; a < 2; ++a)
#pragma unroll
        for (int b = 0; b < 2; ++b)
#pragma unroll
            for (int m = 0; m < 4; ++m)
#pragma unroll
                for (int n = 0; n < 2; ++n) acc[a][b][m][n] = (f32x4){0.f, 0.f, 0.f, 0.f};
    bf16x8 At[4][2], B0[2][2], B1[2][2];
    const char* cA = (const char*)g.A + cur.ao * 2; const char* cB = (const char*)g.Bt + cur.bo * 2;
    PG8_STAGE(PG8_SB(0, 0), cB, voffB); PG8_STAGE(PG8_SB(0, 1), cB + hstepB, voffB); PG8_STAGE(PG8_SA(0, 0), cA, voffA); PG8_STAGE(PG8_SA(0, 1), cA + hstepA, voffA);
    if (wr == 1) PG8_BAR;
    PG8_WAIT_V(2); PG8_BAR;
    PG8_STAGE(PG8_SB(1, 0), cB + kstep, voffB); PG8_STAGE(PG8_SA(1, 0), cA + kstep, voffA); PG8_STAGE(PG8_SB(1, 1), cB + hstepB + kstep, voffB);
    PG8_WAIT_V(6); PG8_BAR;
    for (;;) {
        const bool has_next = S.next(ui + 1, nxt);
        const char* nA = has_next ? (const char*)g.A + nxt.ao * 2 : cA; const char* nB = has_next ? (const char*)g.Bt + nxt.bo * 2 : cB;
        for (int t = 0; t < nt; t += 2) {
            const bool last = (t == nt - 2);
            const char* a1 = cA + (size_t)(t + 1) * kstep;
            const char* a2 = last ? nA : cA + (size_t)(t + 2) * kstep; const char* b2 = last ? nB : cB + (size_t)(t + 2) * kstep;
            const char* a3 = a2 + kstep; const char* b3 = b2 + kstep;
            PG8_LDB(B0, 0, 0); PG8_LDB(B1, 0, 1); PG8_SCHED; PG8_LDA(At, 0, 0); PG8_STAGE(PG8_SA(1, 1), a1 + hstepA, voffA);
            PG8_WAIT_V(8); PG8_WAIT_L(0); PG8_BAR; PG8_MMA(0, 0, At, B0); PG8_MMA(0, 1, At, B1); PG8_BAR; PG8_SCHED;
            PG8_LDA(At, 0, 1); PG8_STAGE(PG8_SB(0, 0), b2, voffB); PG8_STAGE(PG8_SB(0, 1), b2 + hstepB, voffB); PG8_STAGE(PG8_SA(0, 0), a2, voffA);
            PG8_WAIT_V(8); PG8_WAIT_L(0); PG8_BAR; PG8_MMA(1, 0, At, B0); PG8_MMA(1, 1, At, B1); PG8_BAR; PG8_SCHED;
            PG8_LDB(B0, 1, 0); PG8_LDB(B1, 1, 1); PG8_SCHED; PG8_LDA(At, 1, 0); PG8_STAGE(PG8_SA(0, 1), a2 + hstepA, voffA);
            PG8_WAIT_V(8); PG8_WAIT_L(0); PG8_BAR; PG8_MMA(0, 0, At, B0); PG8_MMA(0, 1, At, B1); PG8_BAR; PG8_SCHED;
            PG8_LDA(At, 1, 1); PG8_STAGE(PG8_SB(1, 0), b3, voffB); PG8_STAGE(PG8_SB(1, 1), b3 + hstepB, voffB); PG8_STAGE(PG8_SA(1, 0), a3, voffA);
            PG8_WAIT_V(8); PG8_WAIT_L(0); PG8_BAR; PG8_MMA(1, 0, At, B0); PG8_MMA(1, 1, At, B1); PG8_BAR; PG8_SCHED;
        }
        if constexpr (ALIGN_EPI) { if (wr == 0) PG8_BAR; }
        E(acc, cur, wr, wc, fr, fq, lds);
        if (!has_next) break;
#pragma unroll
        for (int a = 0; a < 2; ++a)
#pragma unroll
            for (int b = 0; b < 2; ++b)
#pragma unroll
                for (int m = 0; m < 4; ++m)
#pragma unroll
                    for (int n = 0; n < 2; ++n) acc[a][b][m][n] = (f32x4){0.f, 0.f, 0.f, 0.f};
        cur = nxt; cA = nA; cB = nB; ++ui;
        if constexpr (ALIGN_EPI) { if (wr == 1) PG8_BAR; }
    }
    PG8_WAIT_V(0);
    if constexpr (!ALIGN_EPI) { if (wr == 0) PG8_BAR; }
    PG8_BAR;
#undef PG8_SA
#undef PG8_SB
#undef PG8_STAGE
#undef PG8_LDA
#undef PG8_LDB
#undef PG8_MMA
#undef PG8_WAIT_V
#undef PG8_WAIT_L
#undef PG8_BAR
#undef PG8_SCHED
}

struct EpiStore {
    static constexpr bool PERM = true;
    bf16_t* O; int ldc; float scale; const float* rowscale; int rs_stride;
    DI void operator()(const Acc& acc, const Unit& u, int wr, int wc, int fr, int fq, LAS unsigned char*) const {
        const int row0 = u.pm * BM + wr * 64 + fr, col0 = u.pn * BM + wc * 32 + 8 * fq;
#pragma unroll
        for (int ai = 0; ai < 2; ++ai)
#pragma unroll
            for (int m = 0; m < 4; ++m) { const int row = row0 + ai * HALF + m * 16; bf16_t* rowp = O + (size_t)row * ldc + col0;
                const float sc = rowscale ? scale * rowscale[(size_t)row * rs_stride] : scale;
#pragma unroll
                for (int bj = 0; bj < 2; ++bj) { const f32x4 v0 = acc[ai][bj][m][0] * sc, v1 = acc[ai][bj][m][1] * sc;
                    u32x4 w; w.x = cvtpk(v0[0], v0[1]); w.y = cvtpk(v0[2], v0[3]); w.z = cvtpk(v1[0], v1[1]); w.w = cvtpk(v1[2], v1[3]);
                    *(u32x4*)(rowp + bj * HALF) = w; } CFENCE(); }
    }
};
struct EpiRelu2 {
    static constexpr bool PERM = true;
    bf16_t* O; int ldc;
    DI void operator()(const Acc& acc, const Unit& u, int wr, int wc, int fr, int fq, LAS unsigned char*) const {
        const int row0 = u.pm * BM + wr * 64 + fr, col0 = u.pn * BM + wc * 32 + 8 * fq;
#pragma unroll
        for (int ai = 0; ai < 2; ++ai)
#pragma unroll
            for (int m = 0; m < 4; ++m) { bf16_t* rowp = O + (size_t)(row0 + ai * HALF + m * 16) * ldc + col0;
#pragma unroll
                for (int bj = 0; bj < 2; ++bj) { f32x4 v0 = acc[ai][bj][m][0], v1 = acc[ai][bj][m][1];
#pragma unroll
                    for (int j = 0; j < 4; ++j) { const float a = fmaxf(v0[j], 0.f), b = fmaxf(v1[j], 0.f); v0[j] = a * a; v1[j] = b * b; }
                    u32x4 w; w.x = cvtpk(v0[0], v0[1]); w.y = cvtpk(v0[2], v0[3]); w.z = cvtpk(v1[0], v1[1]); w.w = cvtpk(v1[2], v1[3]);
                    *(u32x4*)(rowp + bj * HALF) = w; } CFENCE(); }
    }
};
struct EpiQ {
    static constexpr bool PERM = false;
    bf16_t* O; const float* rms; const float* cs; float scale;
    DI void operator()(const Acc& acc, const Unit& u, int wr, int wc, int fr, int fq, LAS unsigned char*) const {
#pragma unroll
        for (int ai = 0; ai < 2; ++ai)
#pragma unroll
            for (int m = 0; m < 4; ++m) { const int row = u.pm * BM + ai * HALF + wr * 64 + m * 16 + fr;
                const float sc = rms[(size_t)row * 2] * scale;
                const f32x4 cv0 = *(const f32x4*)(cs + (size_t)row * 32 + 8 * fq), cv1 = *(const f32x4*)(cs + (size_t)row * 32 + 8 * fq + 4);
                const float cc[4] = {cv0[0], cv0[2], cv1[0], cv1[2]}, ss[4] = {cv0[1], cv0[3], cv1[1], cv1[3]};
#pragma unroll
                for (int bj = 0; bj < 2; ++bj) { const int cg32 = u.pn * 8 + bj * 4 + wc; const int col = cg32 * 32 + 4 * fq;
                    f32x4 x1 = acc[ai][bj][m][0] * sc, x2 = acc[ai][bj][m][1] * sc;
                    if ((cg32 % 3) == 2) {
#pragma unroll
                        for (int j = 0; j < 4; ++j) { const float a = x1[j], b = x2[j]; x1[j] = a * cc[j] - b * ss[j]; x2[j] = a * ss[j] + b * cc[j]; }
                    }
                    u32x2 w0, w1; w0.x = cvtpk(x1[0], x1[1]); w0.y = cvtpk(x1[2], x1[3]); w1.x = cvtpk(x2[0], x2[1]); w1.y = cvtpk(x2[2], x2[3]);
                    bf16_t* p = O + (size_t)row * 768 + col; *(u32x2*)p = w0; *(u32x2*)(p + 16) = w1; } CFENCE(); }
    }
};
struct EpiGlu {
    static constexpr bool PERM = true;
    bf16_t* O; const bf16_t* z;
    DI void operator()(const Acc& acc, const Unit& u, int wr, int wc, int fr, int fq, LAS unsigned char*) const {
        const int row0 = u.pm * BM + wr * 64 + fr, col0 = u.pn * HALF + wc * 32 + 8 * fq;
#pragma unroll
        for (int ai = 0; ai < 2; ++ai)
#pragma unroll
            for (int m = 0; m < 4; ++m) { const int row = row0 + ai * HALF + m * 16;
                const u32x4 gz = *(const u32x4*)(z + (size_t)row * ZW + Z_GS + col0);
                const float gs[8] = {bflo(gz.x), bfhi(gz.x), bflo(gz.y), bfhi(gz.y), bflo(gz.z), bfhi(gz.z), bflo(gz.w), bfhi(gz.w)};
                float o[8];
#pragma unroll
                for (int n = 0; n < 2; ++n)
#pragma unroll
                    for (int j = 0; j < 4; ++j) o[4 * n + j] = acc[ai][0][m][n][j] * sigmoidf_(acc[ai][1][m][n][j]) * sigmoidf_(gs[4 * n + j]);
                u32x4 w; w.x = cvtpk(o[0], o[1]); w.y = cvtpk(o[2], o[3]); w.z = cvtpk(o[4], o[5]); w.w = cvtpk(o[6], o[7]);
                *(u32x4*)(O + (size_t)row * D + col0) = w; CFENCE(); }
    }
};
struct EpiOa {
    static constexpr bool PERM = true;
    bf16_t* O; const bf16_t* sg; const bf16_t* z;
    DI void operator()(const Acc& acc, const Unit& u, int wr, int wc, int fr, int fq, LAS unsigned char*) const {
        const int row0 = u.pm * BM + wr * 64 + fr, col0 = u.pn * BM + wc * 32 + 8 * fq;
#pragma unroll
        for (int ai = 0; ai < 2; ++ai)
#pragma unroll
            for (int m = 0; m < 4; ++m) { const int row = row0 + ai * HALF + m * 16;
#pragma unroll
                for (int bj = 0; bj < 2; ++bj) { const int col = col0 + bj * HALF;
                    const u32x4 gz = *(const u32x4*)(z + (size_t)row * ZW + Z_GA + col), sv = *(const u32x4*)(sg + (size_t)row * D + col);
                    const float ga[8] = {bflo(gz.x), bfhi(gz.x), bflo(gz.y), bfhi(gz.y), bflo(gz.z), bfhi(gz.z), bflo(gz.w), bfhi(gz.w)};
                    const float s8[8] = {bflo(sv.x), bfhi(sv.x), bflo(sv.y), bfhi(sv.y), bflo(sv.z), bfhi(sv.z), bflo(sv.w), bfhi(sv.w)};
                    float o[8];
#pragma unroll
                    for (int n = 0; n < 2; ++n)
#pragma unroll
                        for (int j = 0; j < 4; ++j) o[4 * n + j] = s8[4 * n + j] + sigmoidf_(ga[4 * n + j]) * acc[ai][bj][m][n][j];
                    u32x4 w; w.x = cvtpk(o[0], o[1]); w.y = cvtpk(o[2], o[3]); w.z = cvtpk(o[4], o[5]); w.w = cvtpk(o[6], o[7]);
                    *(u32x4*)(O + (size_t)row * D + col) = w; } CFENCE(); }
    }
};
struct EpiRes {
    static constexpr bool PERM = false;
    float* out; const float* src; const float* stats; const float* g; const float* b;
    DI void operator()(const Acc& acc, const Unit& u, int wr, int wc, int fr, int fq, LAS unsigned char*) const {
        const int col0 = u.pn * BM + wc * 32 + 4 * fq;
        f32x4 gv[2][2], bv[2][2];
#pragma unroll
        for (int bj = 0; bj < 2; ++bj)
#pragma unroll
            for (int n = 0; n < 2; ++n) { gv[bj][n] = *(const f32x4*)(g + col0 + bj * HALF + n * 16) * DN_ALPHA; bv[bj][n] = *(const f32x4*)(b + col0 + bj * HALF + n * 16) * DN_ALPHA; }
#pragma unroll
        for (int ai = 0; ai < 2; ++ai)
#pragma unroll
            for (int m = 0; m < 4; ++m) { const int row = u.pm * BM + ai * HALF + wr * 64 + m * 16 + fr; const size_t off = (size_t)row * D + col0;
                const f32x2 st = *(const f32x2*)(stats + (size_t)row * 2);
#pragma unroll
                for (int bj = 0; bj < 2; ++bj)
#pragma unroll
                    for (int n = 0; n < 2; ++n) { const f32x4 s = *(const f32x4*)(src + off + bj * HALF + n * 16);
                        const f32x4 o = (s - st.x) * st.y * gv[bj][n] + bv[bj][n] + acc[ai][bj][m][n];
                        *(f32x4*)(out + off + bj * HALF + n * 16) = o; } CFENCE(); }
    }
};
struct EpiSoftmax {
    static constexpr bool PERM = true;
    bf16_t* P; float* rs4;
    DI void operator()(const Acc& acc, const Unit& u, int wr, int wc, int fr, int fq, LAS unsigned char* lds) const {
        LAS float* X = (LAS float*)(lds + LDS_XCH);
        float mrow[2][4];
#pragma unroll
        for (int ai = 0; ai < 2; ++ai)
#pragma unroll
            for (int m = 0; m < 4; ++m) { float mx = -3.0e38f;
#pragma unroll
                for (int bj = 0; bj < 2; ++bj)
#pragma unroll
                    for (int n = 0; n < 2; ++n)
#pragma unroll
                        for (int j = 0; j < 4; ++j) mx = fmaxf(mx, acc[ai][bj][m][n][j]);
                mx = fmaxf(mx, __shfl_xor(mx, 16)); mx = fmaxf(mx, __shfl_xor(mx, 32));
                if (fq == 0) X[(ai * HALF + wr * 64 + m * 16 + fr) * 4 + wc] = mx; }
        asm volatile("s_waitcnt lgkmcnt(0)" ::: "memory"); __builtin_amdgcn_s_barrier(); asm volatile("" ::: "memory");
#pragma unroll
        for (int ai = 0; ai < 2; ++ai)
#pragma unroll
            for (int m = 0; m < 4; ++m) { const f32x4 v = *(const LAS f32x4*)(X + (ai * HALF + wr * 64 + m * 16 + fr) * 4); mrow[ai][m] = fmaxf(fmaxf(v[0], v[1]), fmaxf(v[2], v[3])); }
        const int row0 = u.pm * BM + wr * 64 + fr, col0 = u.pn * BM + wc * 32 + 8 * fq;
#pragma unroll
        for (int ai = 0; ai < 2; ++ai)
#pragma unroll
            for (int m = 0; m < 4; ++m) { const int row = row0 + ai * HALF + m * 16; float sum = 0.f; const float mr = mrow[ai][m];
#pragma unroll
                for (int bj = 0; bj < 2; ++bj) { float e[8];
#pragma unroll
                    for (int n = 0; n < 2; ++n)
#pragma unroll
                        for (int j = 0; j < 4; ++j) { e[4 * n + j] = __builtin_amdgcn_exp2f(acc[ai][bj][m][n][j] - mr); sum += e[4 * n + j]; }
                    u32x4 w; w.x = cvtpk(e[0], e[1]); w.y = cvtpk(e[2], e[3]); w.z = cvtpk(e[4], e[5]); w.w = cvtpk(e[6], e[7]);
                    *(u32x4*)(P + (size_t)row * D + col0 + bj * HALF) = w; }
                sum += __shfl_xor(sum, 16); sum += __shfl_xor(sum, 32);
                if (fq == 0) rs4[((size_t)row * 4 + u.pn) * 4 + wc] = sum; CFENCE(); }
        asm volatile("s_waitcnt lgkmcnt(0)" ::: "memory"); __builtin_amdgcn_s_barrier(); asm volatile("" ::: "memory");
    }
};
struct EpiPV {
    static constexpr bool PERM = true;
    bf16_t* O; const float* rs4;
    DI void operator()(const Acc& acc, const Unit& u, int wr, int wc, int fr, int fq, LAS unsigned char*) const {
        const int row0 = u.pm * BM + wr * 64 + fr, col0 = u.pn * BM + wc * 32 + 8 * fq;
#pragma unroll
        for (int ai = 0; ai < 2; ++ai)
#pragma unroll
            for (int m = 0; m < 4; ++m) { const int row = row0 + ai * HALF + m * 16; bf16_t* rowp = O + (size_t)row * D + col0;
                const f32x4 r4 = *(const f32x4*)(rs4 + ((size_t)row * 4 + u.pn) * 4); const float sc = 1.0f / ((r4[0] + r4[1]) + (r4[2] + r4[3]));
#pragma unroll
                for (int bj = 0; bj < 2; ++bj) { const f32x4 v0 = acc[ai][bj][m][0] * sc, v1 = acc[ai][bj][m][1] * sc;
                    u32x4 w; w.x = cvtpk(v0[0], v0[1]); w.y = cvtpk(v0[2], v0[3]); w.z = cvtpk(v1[0], v1[1]); w.w = cvtpk(v1[2], v1[3]);
                    *(u32x4*)(rowp + bj * HALF) = w; } CFENCE(); }
    }
};
}

struct Args { const void* in[33]; float* out; unsigned char* ws; int ph_lo, ph_hi, coop, pad; };
enum { I_X = 0, I_MEM, I_POS, I_LNING, I_LNINB, I_WIN, I_LAMRE, I_LAMIM, I_LOGDT, I_BRE, I_BIM, I_CRE, I_CIM, I_DSKIP, I_WGLU, I_QNG, I_WUQ, I_KVNG, I_WUKV,
       I_WOA, I_WO, I_LN1G, I_LN1B, I_WXQ, I_WXK, I_WXV, I_WXO, I_LN2G, I_LN2B, I_WUP, I_WDOWN, I_LN3G, I_LN3B };

template <int MODE>
DI void transpose_item(const float* W, int K, int N, bf16_t* WT, int row_off, const float* kscale, LAS float* scr, int item, int lane) {
    const int nblk = N / 32, kb = item / nblk, nb = item % nblk, k0 = 64 * kb, n0 = 32 * nb;
#pragma unroll 8
    for (int i = 0; i < 32; ++i) { const int kk = 2 * i + (lane >> 5); float v = W[(size_t)(k0 + kk) * N + n0 + (lane & 31)]; if (kscale) v *= kscale[k0 + kk]; scr[kk * 33 + (lane & 31)] = v; }
    LDS_WAIT();
    const int c = lane & 7;
#pragma unroll
    for (int j = 0; j < 4; ++j) { const int n = (lane >> 3) + 8 * j; const LAS float* s = scr + (8 * c) * 33 + n;
        u32x4 o; o.x = cvtpk(s[0 * 33], s[1 * 33]); o.y = cvtpk(s[2 * 33], s[3 * 33]); o.z = cvtpk(s[4 * 33], s[5 * 33]); o.w = cvtpk(s[6 * 33], s[7 * 33]);
        int nn = n0 + n, dst;
        if (MODE == 1) { const int half = nn >= 1024, n2 = nn & 1023; dst = 256 * (n2 >> 7) + 128 * half + (n2 & 127); } else dst = row_off + nn;
        *(u32x4*)(WT + (size_t)dst * K + k0 + 8 * c) = o; }
    LDS_WAIT();
}
DI void ln_row(const float* xrow, const float* g, const float* b, bf16_t* obf, float* of32, float* stat, int lane) {
    const f32x4* xr = (const f32x4*)xrow + lane;
    f32x4 v[4]; float s = 0.f;
#pragma unroll
    for (int j = 0; j < 4; ++j) { v[j] = xr[64 * j]; s += (v[j][0] + v[j][1]) + (v[j][2] + v[j][3]); }
    const float mean = wave_sum(s) * (1.f / D); float s2 = 0.f;
#pragma unroll
    for (int j = 0; j < 4; ++j) { v[j] = v[j] - mean; s2 += (v[j][0] * v[j][0] + v[j][1] * v[j][1]) + (v[j][2] * v[j][2] + v[j][3] * v[j][3]); }
    const float rstd = 1.0f / sqrtf(wave_sum(s2) * (1.f / D) + LN_EPS);
    if (stat && lane == 0) { stat[0] = mean; stat[1] = rstd; }
#pragma unroll
    for (int j = 0; j < 4; ++j) { const f32x4 gg = *((const f32x4*)g + lane + 64 * j), bb = *((const f32x4*)b + lane + 64 * j);
        const f32x4 o = v[j] * rstd * gg + bb;
        if (obf) { u32x2 w; w.x = cvtpk(o[0], o[1]); w.y = cvtpk(o[2], o[3]); *((u32x2*)obf + lane + 64 * j) = w; }
        if (of32) *((f32x4*)of32 + lane + 64 * j) = o; }
}

template <int PASS>
DI void s5_task(LAS unsigned char* lds, const unsigned char* ws, const float* dskip, int task, int wid, int lane) {
    const bf16_t* z = (const bf16_t*)(ws + WS_Z);
    float* E = (float*)(ws + WS_E);
    bf16_t* yg = (bf16_t*)(ws + WS_YG);
    const int chunk = task & (NCHUNK - 1), g = (task >> 4) & 15, b = task >> 8;
    const int r32 = lane & 31, hi = lane >> 5, fr = lane & 15, fq = lane >> 4;
    LAS float* sb = (LAS float*)(lds + wid * 16896);
    const float* s5t = (const float*)(ws + WS_S5T);
    const float ar = s5t[(g * 64 + lane) * 2], ai = s5t[(g * 64 + lane) * 2 + 1];
    bf16x8 bh[4], bl[4];
#pragma unroll
    for (int blk = 0; blk < 4; ++blk) { bh[blk] = *(const bf16x8*)(ws + WS_S5T + S5_BHI + ((size_t)(g * 128 + blk * 32 + r32) * 16 + 8 * hi) * 2);
                                        bl[blk] = *(const bf16x8*)(ws + WS_S5T + S5_BLO + ((size_t)(g * 128 + blk * 32 + r32) * 16 + 8 * hi) * 2); }
    bf16x8 ch[4], cl[4];
    float dsk = 0.f;
    if (PASS == 1) {
#pragma unroll
        for (int ks = 0; ks < 4; ++ks) { ch[ks] = *(const bf16x8*)(ws + WS_S5T + S5_CHI + ((size_t)(g * 16 + fr) * 128 + 32 * ks + 8 * fq) * 2);
                                         cl[ks] = *(const bf16x8*)(ws + WS_S5T + S5_CLO + ((size_t)(g * 16 + fr) * 128 + 32 * ks + 8 * fq) * 2); }
        dsk = dskip[g * 16 + fr];
    }
    float hr = 0.f, hi_ = 0.f;
    if (PASS == 1) {
        const float pr = s5t[S5_APOW / 4 + (g * 64 + lane) * 2], pi = s5t[S5_APOW / 4 + (g * 64 + lane) * 2 + 1];
        const float* Eb = E + ((size_t)(b * 16 + g) * NCHUNK) * 128;
        for (int j = 0; j < chunk; ++j) { const float er = Eb[j * 128 + lane], ei = Eb[j * 128 + 64 + lane];
            const float nr = pr * hr - pi * hi_ + er, ni = pr * hi_ + pi * hr + ei; hr = nr; hi_ = ni; }
    }
    const size_t row0 = (size_t)b * SEQ + (size_t)chunk * CHUNK;
    for (int blk32 = 0; blk32 < CHUNK / 32; ++blk32) {
        const size_t rb = row0 + blk32 * 32;
        const bf16x8 ua = *(const bf16x8*)(z + (rb + r32) * ZW + Z_U + g * 16 + 8 * hi);
#pragma unroll
        for (int blk = 0; blk < 4; ++blk) {
            f32x16 acc = {};
            acc = __builtin_amdgcn_mfma_f32_32x32x16_bf16(ua, bh[blk], acc, 0, 0, 0);
            acc = __builtin_amdgcn_mfma_f32_32x32x16_bf16(ua, bl[blk], acc, 0, 0, 0);
#pragma unroll
            for (int r = 0; r < 16; ++r) sb[crow(r, hi) * 132 + blk * 32 + r32] = acc[r];
        }
        LDS_WAIT();
#pragma unroll
        for (int t = 0; t < 32; ++t) { const float br = sb[t * 132 + lane], bi = sb[t * 132 + 64 + lane];
            const float nr = ar * hr - ai * hi_ + br, ni = ar * hi_ + ai * hr + bi; hr = nr; hi_ = ni;
            if (PASS == 1) { sb[t * 132 + lane] = hr; sb[t * 132 + 64 + lane] = hi_; } }
        if (PASS == 1) {
            LDS_WAIT();
#pragma unroll
            for (int th = 0; th < 2; ++th) {
                f32x4 y = {0.f, 0.f, 0.f, 0.f};
#pragma unroll
                for (int ks = 0; ks < 4; ++ks) {
                    const f32x4 h0 = *(const LAS f32x4*)(sb + (16 * th + fr) * 132 + 32 * ks + 8 * fq), h1 = *(const LAS f32x4*)(sb + (16 * th + fr) * 132 + 32 * ks + 8 * fq + 4);
                    u32x4 ph, pl;
                    ph.x = cvtpk(h0[0], h0[1]); ph.y = cvtpk(h0[2], h0[3]); ph.z = cvtpk(h1[0], h1[1]); ph.w = cvtpk(h1[2], h1[3]);
                    pl.x = cvtpk(h0[0] - bflo(ph.x), h0[1] - bfhi(ph.x)); pl.y = cvtpk(h0[2] - bflo(ph.y), h0[3] - bfhi(ph.y));
                    pl.z = cvtpk(h1[0] - bflo(ph.z), h1[1] - bfhi(ph.z)); pl.w = cvtpk(h1[2] - bflo(ph.w), h1[3] - bfhi(ph.w));
                    const bf16x8 ahi = __builtin_bit_cast(bf16x8, ph), alo = __builtin_bit_cast(bf16x8, pl);
                    y = __builtin_amdgcn_mfma_f32_16x16x32_bf16(ahi, ch[ks], y, 0, 0, 0);
                    y = __builtin_amdgcn_mfma_f32_16x16x32_bf16(alo, ch[ks], y, 0, 0, 0);
                    y = __builtin_amdgcn_mfma_f32_16x16x32_bf16(ahi, cl[ks], y, 0, 0, 0);
                }
#pragma unroll
                for (int r = 0; r < 4; ++r) { const size_t row = rb + 16 * th + 4 * fq + r;
                    const float uv = bf2f(z[row * ZW + Z_U + g * 16 + fr]);
                    const float yv = y[r] + dsk * uv;
                    const float ge = 0.5f * yv * (1.0f + erff(yv * 0.70710678118654752f));
                    yg[row * 256 + g * 16 + fr] = f2bf(ge); }
            }
            LDS_WAIT();
        }
    }
    if (PASS == 0) { float* Eo = E + ((size_t)(b * 16 + g) * NCHUNK + chunk) * 128; Eo[lane] = hr; Eo[64 + lane] = hi_; }
}

DI void attn_phase(LAS unsigned char* lds, const int wid, const bf16_t* Q, const bf16_t* KV, const bf16_t* KR, bf16_t* O) {
    const int lane = lane_id(), tid = wid * 64 + lane, r32 = lane & 31, hi = lane >> 5;
    constexpr int KROW = 208, VROW = 192, KBUF = 64 * KROW, VBUF = 64 * VROW, VOFF = 2 * KBUF;
    const int skey = tid >> 3, sc = tid & 7;
    const int vb0 = VOFF + (4 * hi + ((lane & 15) >> 2)) * VROW + ((lane >> 4) & 1) * 32 + (lane & 3) * 8;
    for (int it = blockIdx.x; it < 2048; it += gridDim.x) {
        const int r = it >> 8, wg = it & 255, bh = wg >> 2, j4 = wg & 3;
        const int qb = (r & 1) ? (4 * (r - 1) + 7 - j4) : (4 * r + j4);
        const int b = bh >> 3, h = bh & 7;
        const size_t rowbase = (size_t)b * SEQ; const int q0 = qb * 256;
        const int NT = 4 * (qb + 1);
        const int jlast = 4 * qb + (wid >> 1);
        const int qrel = 32 * (wid & 1) + r32;
        bf16x8 qr[6];
        { const bf16_t* qp = Q + (rowbase + q0 + wid * 32 + r32) * 768 + h * 96 + hi * 8;
#pragma unroll
          for (int d0 = 0; d0 < 6; ++d0) qr[d0] = *(const bf16x8*)(qp + d0 * 16); }
        const bf16_t* kvsrc = KV + (rowbase + skey) * 1024 + h * 128 + sc * 8;
        const bf16_t* krsrc = KR + (rowbase + (tid >> 2)) * 32 + (tid & 3) * 8;
        u32x4 sk, sv, sr = {0u, 0u, 0u, 0u};
        sk = *(const u32x4*)kvsrc; sv = *(const u32x4*)(kvsrc + 64); if (tid < 256) sr = *(const u32x4*)krsrc;
        float mrun = -1e30f, lrun = 0.f; f32x16 o0 = {}, o1 = {};
        for (int j = 0; j < NT; ++j) {
            const int buf = j & 1;
            *(LAS u32x4*)(lds + buf * KBUF + skey * KROW + sc * 16) = sk;
            *(LAS u32x4*)(lds + VOFF + buf * VBUF + skey * VROW + sc * 16) = sv;
            if (tid < 256) *(LAS u32x4*)(lds + buf * KBUF + (tid >> 2) * KROW + 128 + (tid & 3) * 16) = sr;
            __syncthreads();
            if (j + 1 < NT) { const size_t o = (size_t)(j + 1) * 64;
                sk = *(const u32x4*)(kvsrc + o * 1024); sv = *(const u32x4*)(kvsrc + o * 1024 + 64); if (tid < 256) sr = *(const u32x4*)(krsrc + o * 32); }
            if (j <= jlast) {
                const LAS unsigned char* kb = lds + buf * KBUF + r32 * KROW + hi * 16;
                f32x16 p0 = {}, p1 = {};
#pragma unroll
                for (int d0 = 0; d0 < 6; ++d0) {
                    const bf16x8 k0 = *(const LAS bf16x8*)(kb + d0 * 32), k1 = *(const LAS bf16x8*)(kb + 32 * KROW + d0 * 32);
                    p0 = __builtin_amdgcn_mfma_f32_32x32x16_bf16(k0, qr[d0], p0, 0, 0, 0);
                    p1 = __builtin_amdgcn_mfma_f32_32x32x16_bf16(k1, qr[d0], p1, 0, 0, 0);
                }
                if (j == jlast) {
#pragma unroll
                    for (int rr = 0; rr < 16; ++rr) { const int kv = crow(rr, hi); if (kv > qrel) p0[rr] = -1e30f; if (kv + 32 > qrel) p1[rr] = -1e30f; }
                }
                float mx = fmaxf(p0[0], p1[0]);
#pragma unroll
                for (int rr = 1; rr < 16; ++rr) mx = fmaxf(mx, fmaxf(p0[rr], p1[rr]));
                mx = fmaxf(mx, __shfl_xor(mx, 32));
                const float mnew = fmaxf(mrun, mx);
                const float alpha = __builtin_amdgcn_exp2f(mrun - mnew);
                float sum = 0.f;
#pragma unroll
                for (int rr = 0; rr < 16; ++rr) { p0[rr] = __builtin_amdgcn_exp2f(p0[rr] - mnew); p1[rr] = __builtin_amdgcn_exp2f(p1[rr] - mnew); sum += p0[rr] + p1[rr]; }
                lrun = lrun * alpha + sum; mrun = mnew;
                if (!__all(alpha == 1.0f)) { o0 = o0 * alpha; o1 = o1 * alpha; }
                bf16x8 pb[4];
#pragma unroll
                for (int s = 0; s < 2; ++s) { u32x4 w0, w1;
                    w0.x = cvtpk(p0[8 * s], p0[8 * s + 1]); w0.y = cvtpk(p0[8 * s + 2], p0[8 * s + 3]); w0.z = cvtpk(p0[8 * s + 4], p0[8 * s + 5]); w0.w = cvtpk(p0[8 * s + 6], p0[8 * s + 7]);
                    w1.x = cvtpk(p1[8 * s], p1[8 * s + 1]); w1.y = cvtpk(p1[8 * s + 2], p1[8 * s + 3]); w1.z = cvtpk(p1[8 * s + 4], p1[8 * s + 5]); w1.w = cvtpk(p1[8 * s + 6], p1[8 * s + 7]);
                    pb[s] = __builtin_bit_cast(bf16x8, w0); pb[2 + s] = __builtin_bit_cast(bf16x8, w1); }
                const LAS unsigned char* vb = lds + vb0 + buf * VBUF;
#pragma unroll
                for (int s = 0; s < 4; ++s) {
#pragma unroll
                    for (int d0 = 0; d0 < 2; ++d0) {
                        const s16x4 lo = __builtin_bit_cast(s16x4, __builtin_amdgcn_ds_read_tr16_b64_v4i16((LAS s16x4*)(vb + s * 16 * VROW + d0 * 64)));
                        const s16x4 hh = __builtin_bit_cast(s16x4, __builtin_amdgcn_ds_read_tr16_b64_v4i16((LAS s16x4*)(vb + s * 16 * VROW + 8 * VROW + d0 * 64)));
                        const bf16x8 vf = (bf16x8){lo[0], lo[1], lo[2], lo[3], hh[0], hh[1], hh[2], hh[3]};
                        if (d0 == 0) o0 = __builtin_amdgcn_mfma_f32_32x32x16_bf16(vf, pb[s], o0, 0, 0, 0);
                        else         o1 = __builtin_amdgcn_mfma_f32_32x32x16_bf16(vf, pb[s], o1, 0, 0, 0);
                    }
                }
            }
        }
        const float ltot = lrun + __shfl_xor(lrun, 32); const float inv = 1.0f / ltot;
        bf16_t* op = O + (rowbase + q0 + wid * 32 + r32) * 512 + h * 64 + 4 * hi;
#pragma unroll
        for (int gq = 0; gq < 4; ++gq) {
            u32x2 w0, w1;
            w0.x = cvtpk(o0[4 * gq] * inv, o0[4 * gq + 1] * inv); w0.y = cvtpk(o0[4 * gq + 2] * inv, o0[4 * gq + 3] * inv);
            w1.x = cvtpk(o1[4 * gq] * inv, o1[4 * gq + 1] * inv); w1.y = cvtpk(o1[4 * gq + 2] * inv, o1[4 * gq + 3] * inv);
            *(u32x2*)(op + 8 * gq) = w0; *(u32x2*)(op + 32 + 8 * gq) = w1;
        }
    }
}

__global__ void __launch_bounds__(NTHREADS, 2) fwd_kernel(Args a) {
    extern __shared__ __attribute__((aligned(16))) unsigned char lds_raw[];
    LAS unsigned char* lds = (LAS unsigned char*)lds_raw;
    const int wid = __builtin_amdgcn_readfirstlane(threadIdx.x >> 6);
    const int G = gridDim.x, bx = blockIdx.x;
    const int gw = bx * NWAVES + wid, NGW = G * NWAVES, NGT = G * NTHREADS;
#define IDS() const int lane = lane_id(); const int gt = bx * NTHREADS + wid * 64 + lane; (void)gt
    unsigned char* ws = a.ws;
    const int lo = a.ph_lo, hi = a.ph_hi;
#ifndef PHASE_MASK
#define PHASE_MASK 0xFFFFFFFFu
#endif
#define IN(k) (((PHASE_MASK >> (k)) & 1u) && lo <= (k) && (k) < hi)
#define SEAM(k) do { if (a.coop && IN(k) && IN((k) + 1)) grid_barrier((unsigned*)ws, (unsigned)((k) + 1) * (unsigned)G, wid); } while (0)
    if (a.coop) cg::this_grid().sync();
    const float* x = (const float*)a.in[I_X];
    bf16_t* z = (bf16_t*)(ws + WS_Z);

    if (IN(0)) {
        IDS();
        LAS float* scr = (LAS float*)(lds + wid * 16384);
        constexpr int IT_IN = (1024 / 64) * (2848 / 32), IT_GLU = (256 / 64) * (2048 / 32), IT_UQ = (256 / 64) * (768 / 32), IT_UKV = (256 / 64) * (1024 / 32), IT_OA = (512 / 64) * (1024 / 32),
                      IT_SQ = (1024 / 64) * (1024 / 32), IT_UP = (1024 / 64) * (4096 / 32), IT_DN = (4096 / 64) * (1024 / 32);
        constexpr int NITEMS = IT_IN + IT_GLU + IT_UQ + IT_UKV + IT_OA + 5 * IT_SQ + IT_UP + IT_DN;
        for (int it = gw; it < NITEMS; it += NGW) {
            int r = it;
            if (r < IT_IN) { transpose_item<0>((const float*)a.in[I_WIN], 1024, 2848, (bf16_t*)(ws + W_IN), 0, nullptr, scr, r, lane); continue; } r -= IT_IN;
            if (r < IT_GLU) { transpose_item<1>((const float*)a.in[I_WGLU], 256, 2048, (bf16_t*)(ws + W_GLU), 0, nullptr, scr, r, lane); continue; } r -= IT_GLU;
            if (r < IT_UQ) { transpose_item<0>((const float*)a.in[I_WUQ], 256, 768, (bf16_t*)(ws + W_UQ), 0, (const float*)a.in[I_QNG], scr, r, lane); continue; } r -= IT_UQ;
            if (r < IT_UKV) { transpose_item<0>((const float*)a.in[I_WUKV], 256, 1024, (bf16_t*)(ws + W_UKV), 0, (const float*)a.in[I_KVNG], scr, r, lane); continue; } r -= IT_UKV;
            if (r < IT_OA) { transpose_item<0>((const float*)a.in[I_WOA], 512, 1024, (bf16_t*)(ws + W_OA), 0, nullptr, scr, r, lane); continue; } r -= IT_OA;
            if (r < IT_SQ) { transpose_item<0>((const float*)a.in[I_WO], 1024, 1024, (bf16_t*)(ws + W_O), 0, nullptr, scr, r, lane); continue; } r -= IT_SQ;
            if (r < IT_SQ) { transpose_item<0>((const float*)a.in[I_WXQ], 1024, 1024, (bf16_t*)(ws + W_XQ), 0, nullptr, scr, r, lane); continue; } r -= IT_SQ;
            if (r < IT_SQ) { transpose_item<0>((const float*)a.in[I_WXK], 1024, 1024, (bf16_t*)(ws + W_XKV), 0, nullptr, scr, r, lane); continue; } r -= IT_SQ;
            if (r < IT_SQ) { transpose_item<0>((const float*)a.in[I_WXV], 1024, 1024, (bf16_t*)(ws + W_XKV), 1024, nullptr, scr, r, lane); continue; } r -= IT_SQ;
            if (r < IT_SQ) { transpose_item<0>((const float*)a.in[I_WXO], 1024, 1024, (bf16_t*)(ws + W_XO), 0, nullptr, scr, r, lane); continue; } r -= IT_SQ;
            if (r < IT_UP) { transpose_item<0>((const float*)a.in[I_WUP], 1024, 4096, (bf16_t*)(ws + W_UP), 0, nullptr, scr, r, lane); continue; } r -= IT_UP;
            transpose_item<0>((const float*)a.in[I_WDOWN], 4096, 1024, (bf16_t*)(ws + W_DOWN), 0, nullptr, scr, r, lane);
        }
        for (int i = gt; i < (3072 - 2848) * 1024 / 8; i += NGT) *((u32x4*)(ws + W_IN + (size_t)2848 * 1024 * 2) + i) = (u32x4){0u, 0u, 0u, 0u};
        for (int m = gw; m < T; m += NGW) ln_row(x + (size_t)m * D, (const float*)a.in[I_LNING], (const float*)a.in[I_LNINB], (bf16_t*)(ws + WS_HN) + (size_t)m * D, nullptr, (float*)(ws + WS_STAT0) + (size_t)m * 2, lane);
        { const float* mem = (const float*)a.in[I_MEM]; bf16_t* mb = (bf16_t*)(ws + WS_MEMB);
          for (int i = gt; i < BATCH * MEMT * D / 4; i += NGT) { const f32x4 v = *((const f32x4*)mem + i); u32x2 w; w.x = cvtpk(v[0], v[1]); w.y = cvtpk(v[2], v[3]); *((u32x2*)mb + i) = w; } }
        { const int* pos = (const int*)a.in[I_POS]; float* cs = (float*)(ws + WS_CS);
          for (int i = gt; i < T * 16; i += NGT) { const int row = i >> 4, k = i & 15;
              const float inv = exp2f(-(float)k * (13.287712379549449f / 16.0f));
              const float ang = (float)pos[row] * inv; double s, c; sincos_d((double)ang, s, c);
              *(f32x2*)(cs + (size_t)i * 2) = (f32x2){(float)c, (float)s}; } }
        if (gt < 16 * 64) {
            const int g = gt >> 6, p = gt & 63;
            const float lrf = fminf(((const float*)a.in[I_LAMRE])[gt], -1e-4f), lif = ((const float*)a.in[I_LAMIM])[gt];
            const double lr = lrf, li = lif, dt = exp_d((double)((const float*)a.in[I_LOGDT])[g]);
            const double mag = exp_d(lr * dt); double sn, cn; sincos_d(li * dt, sn, cn);
            const double abr = mag * cn, abi = mag * sn;
            float* s5t = (float*)(ws + WS_S5T);
            s5t[gt * 2] = (float)abr; s5t[gt * 2 + 1] = (float)abi;
            double pr = abr, pi = abi;
            for (int i = 0; i < 9; ++i) { const double nr = pr * pr - pi * pi, ni = 2.0 * pr * pi; pr = nr; pi = ni; }
            s5t[S5_APOW / 4 + gt * 2] = (float)pr; s5t[S5_APOW / 4 + gt * 2 + 1] = (float)pi;
            const double den = lr * lr + li * li, nrr = abr - 1.0;
            const double fre = (nrr * lr + abi * li) / den, fim = (abi * lr - nrr * li) / den;
            bf16_t* BH = (bf16_t*)(ws + WS_S5T + S5_BHI); bf16_t* BL = (bf16_t*)(ws + WS_S5T + S5_BLO);
            bf16_t* CH = (bf16_t*)(ws + WS_S5T + S5_CHI); bf16_t* CL = (bf16_t*)(ws + WS_S5T + S5_CLO);
            for (int c = 0; c < 16; ++c) {
                const double br = ((const float*)a.in[I_BRE])[gt * 16 + c], bi = ((const float*)a.in[I_BIM])[gt * 16 + c];
                const float bbr = (float)(fre * br - fim * bi), bbi = (float)(fre * bi + fim * br);
                const bf16_t h0 = f2bf(bbr), h1 = f2bf(bbi);
                BH[(g * 128 + p) * 16 + c] = h0; BL[(g * 128 + p) * 16 + c] = f2bf(bbr - bf2f(h0));
                BH[(g * 128 + 64 + p) * 16 + c] = h1; BL[(g * 128 + 64 + p) * 16 + c] = f2bf(bbi - bf2f(h1));
                const float cr = ((const float*)a.in[I_CRE])[(g * 16 + c) * 64 + p], ci = -((const float*)a.in[I_CIM])[(g * 16 + c) * 64 + p];
                const bf16_t c0 = f2bf(cr), c1 = f2bf(ci);
                CH[(g * 16 + c) * 128 + p] = c0; CL[(g * 16 + c) * 128 + p] = f2bf(cr - bf2f(c0));
                CH[(g * 16 + c) * 128 + 64 + p] = c1; CL[(g * 16 + c) * 128 + 64 + p] = f2bf(ci - bf2f(c1));
            }
        }
        __syncthreads();
    }
    SEAM(0);

    if (IN(1)) {
        { pg8::Gemm g{(const bf16_t*)(ws + WS_HN), (const bf16_t*)(ws + W_IN), 1024, 1024, 1024}; pg8::StdOrder S; S.init(T, ZW, 1024, 1024, G, bx);
          pg8::EpiStore E{z, ZW, 1.0f, nullptr, 0};
          pg8::gemm_phase<pg8::EpiStore, pg8::StdOrder, true>(lds, wid, g, S, E); }
        { pg8::Gemm g{(const bf16_t*)(ws + WS_MEMB), (const bf16_t*)(ws + W_XKV), 1024, 1024, 1024}; pg8::StdOrder S; S.init(BATCH * MEMT, 2048, 1024, 1024, G, bx);
          pg8::EpiStore E{(bf16_t*)(ws + WS_KVX), 2048, 1.0f, nullptr, 0};
          pg8::gemm_phase<pg8::EpiStore, pg8::StdOrder, true>(lds, wid, g, S, E); }
    }
    SEAM(1);

    if (IN(2)) {
        IDS();
        { float* rms = (float*)(ws + WS_RMS); const float* cs = (const float*)(ws + WS_CS); bf16_t* kr = (bf16_t*)(ws + WS_KR);
          for (int m = gw; m < T; m += NGW) {
              const bf16_t* zr = z + (size_t)m * ZW;
              const u32x4 v = *(const u32x4*)(zr + Z_CQ + 8 * lane);
              const float e[8] = {bflo(v.x), bfhi(v.x), bflo(v.y), bfhi(v.y), bflo(v.z), bfhi(v.z), bflo(v.w), bfhi(v.w)};
              float s = 0.f;
#pragma unroll
              for (int j = 0; j < 8; ++j) s += e[j] * e[j];
#pragma unroll
              for (int o = 1; o < 32; o <<= 1) s += __shfl_xor(s, o);
              if ((lane & 31) == 0) rms[(size_t)m * 2 + (lane >> 5)] = 1.0f / sqrtf(s * (1.0f / 256.0f) + RMS_EPS);
              if (lane < 16) { const float x1 = bf2f(zr[Z_KR + lane]), x2 = bf2f(zr[Z_KR + 16 + lane]); const f32x2 c2 = *(const f32x2*)(cs + ((size_t)m * 16 + lane) * 2);
                  kr[(size_t)m * 32 + lane] = f2bf(x1 * c2.x - x2 * c2.y); kr[(size_t)m * 32 + 16 + lane] = f2bf(x1 * c2.y + x2 * c2.x); }
          } }
        { const bf16_t* kvx = (const bf16_t*)(ws + WS_KVX); bf16_t* vxt = (bf16_t*)(ws + WS_VXT);
          for (int i = gt; i < BATCH * 4 * 256 * 256; i += NGT) { const int key = i & 255, dim = (i >> 8) & 255, h = (i >> 16) & 3, b = i >> 18;
              vxt[i] = kvx[(size_t)(b * 256 + key) * 2048 + 1024 + h * 256 + dim]; } }
        for (int task = gw; task < BATCH * 16 * NCHUNK; task += NGW) s5_task<0>(lds, ws, nullptr, task, wid, lane);
        __syncthreads();
    }
    SEAM(2);

    if (IN(3)) {
        IDS();
        for (int task = gw; task < BATCH * 16 * NCHUNK; task += NGW) s5_task<1>(lds, ws, (const float*)a.in[I_DSKIP], task, wid, lane);
        __syncthreads();
    }
    SEAM(3);

    if (IN(4)) {
#ifndef P4SEL
#define P4SEL 7
#endif
        if (P4SEL & 1) { pg8::Gemm g{z + Z_CQ, (const bf16_t*)(ws + W_UQ), ZW, 256, 256}; pg8::StdOrder S; S.init(T, 768, ZW, 256, G, bx);
          pg8::EpiQ E{(bf16_t*)(ws + WS_Q), (const float*)(ws + WS_RMS), (const float*)(ws + WS_CS), 0.10206207261596577f * LOG2E};
          pg8::gemm_phase<pg8::EpiQ, pg8::StdOrder, true>(lds, wid, g, S, E); }
        if (P4SEL & 2) { pg8::Gemm g{z + Z_CKV, (const bf16_t*)(ws + W_UKV), ZW, 256, 256}; pg8::StdOrder S; S.init(T, 1024, ZW, 256, G, bx);
          pg8::EpiStore E{(bf16_t*)(ws + WS_KV), 1024, 1.0f, (const float*)(ws + WS_RMS) + 1, 2};
          pg8::gemm_phase<pg8::EpiStore, pg8::StdOrder, true>(lds, wid, g, S, E); }
        if (P4SEL & 4) { pg8::Gemm g{(const bf16_t*)(ws + WS_YG), (const bf16_t*)(ws + W_GLU), 256, 256, 256}; pg8::StdOrder S; S.init(T, 2048, 256, 256, G, bx);
          pg8::EpiGlu E{(bf16_t*)(ws + WS_SG), z};
          pg8::gemm_phase<pg8::EpiGlu, pg8::StdOrder, true>(lds, wid, g, S, E); }
    }
    SEAM(4);

    if (IN(5)) {
        attn_phase(lds, wid, (const bf16_t*)(ws + WS_Q), (const bf16_t*)(ws + WS_KV), (const bf16_t*)(ws + WS_KR), (bf16_t*)(ws + WS_ATT));
        __syncthreads();
    }
    SEAM(5);

    if (IN(6)) {
        pg8::Gemm g{(const bf16_t*)(ws + WS_ATT), (const bf16_t*)(ws + W_OA), 512, 512, 512}; pg8::StdOrder S; S.init(T, 1024, 512, 512, G, bx);
        pg8::EpiOa E{(bf16_t*)(ws + WS_GATED), (const bf16_t*)(ws + WS_SG), z};
        pg8::gemm_phase<pg8::EpiOa, pg8::StdOrder, true>(lds, wid, g, S, E);
    }
    SEAM(6);

    if (IN(7)) {
        pg8::Gemm g{(const bf16_t*)(ws + WS_GATED), (const bf16_t*)(ws + W_O), 1024, 1024, 1024}; pg8::StdOrder S; S.init(T, 1024, 1024, 1024, G, bx);
        pg8::EpiRes E{(float*)(ws + WS_R1), x, (const float*)(ws + WS_STAT0), (const float*)a.in[I_LNING], (const float*)a.in[I_LNINB]};
        pg8::gemm_phase<pg8::EpiRes, pg8::StdOrder, true>(lds, wid, g, S, E);
    }
    SEAM(7);

    if (IN(8)) {
        IDS();
        for (int m = gw; m < T; m += NGW) ln_row((const float*)(ws + WS_R1) + (size_t)m * D, (const float*)a.in[I_LN1G], (const float*)a.in[I_LN1B], (bf16_t*)(ws + WS_H1B) + (size_t)m * D, nullptr, (float*)(ws + WS_STAT1) + (size_t)m * 2, lane);
    }
    SEAM(8);

    if (IN(9)) {
        pg8::Gemm g{(const bf16_t*)(ws + WS_H1B), (const bf16_t*)(ws + W_XQ), 1024, 1024, 1024}; pg8::StdOrder S; S.init(T, 1024, 1024, 1024, G, bx);
        pg8::EpiStore E{(bf16_t*)(ws + WS_XQ), 1024, 0.0625f * LOG2E, nullptr, 0};
        pg8::gemm_phase<pg8::EpiStore, pg8::StdOrder, true>(lds, wid, g, S, E);
    }
    SEAM(9);

    if (IN(10)) {
        pg8::Gemm g{(const bf16_t*)(ws + WS_XQ), (const bf16_t*)(ws + WS_KVX), 1024, 2048, 256}; pg8::XattnOrder S{G, bx, 1024, (long)256 * 2048, 256};
        pg8::EpiSoftmax E{(bf16_t*)(ws + WS_P), (float*)(ws + WS_RS4)};
        pg8::gemm_phase<pg8::EpiSoftmax, pg8::XattnOrder, true>(lds, wid, g, S, E);
    }
    SEAM(10);

    if (IN(11)) {
        pg8::Gemm g{(const bf16_t*)(ws + WS_P), (const bf16_t*)(ws + WS_VXT), 1024, 256, 256}; pg8::XattnOrder S{G, bx, 1024, (long)4 * 65536, 65536};
        pg8::EpiPV E{(bf16_t*)(ws + WS_XOIN), (const float*)(ws + WS_RS4)};
        pg8::gemm_phase<pg8::EpiPV, pg8::XattnOrder, true>(lds, wid, g, S, E);
    }
    SEAM(11);

    if (IN(12)) {
        pg8::Gemm g{(const bf16_t*)(ws + WS_XOIN), (const bf16_t*)(ws + W_XO), 1024, 1024, 1024}; pg8::StdOrder S; S.init(T, 1024, 1024, 1024, G, bx);
        pg8::EpiRes E{(float*)(ws + WS_R2), (const float*)(ws + WS_R1), (const float*)(ws + WS_STAT1), (const float*)a.in[I_LN1G], (const float*)a.in[I_LN1B]};
        pg8::gemm_phase<pg8::EpiRes, pg8::StdOrder, true>(lds, wid, g, S, E);
    }
    SEAM(12);

    if (IN(13)) {
        IDS();
        for (int m = gw; m < T; m += NGW) ln_row((const float*)(ws + WS_R2) + (size_t)m * D, (const float*)a.in[I_LN2G], (const float*)a.in[I_LN2B], (bf16_t*)(ws + WS_H2B) + (size_t)m * D, nullptr, (float*)(ws + WS_STAT2) + (size_t)m * 2, lane);
    }
    SEAM(13);

    if (IN(14)) {
        pg8::Gemm g{(const bf16_t*)(ws + WS_H2B), (const bf16_t*)(ws + W_UP), 1024, 1024, 1024}; pg8::StdOrder S; S.init(T, 4096, 1024, 1024, G, bx);
        pg8::EpiRelu2 E{(bf16_t*)(ws + WS_HID), 4096};
        pg8::gemm_phase<pg8::EpiRelu2, pg8::StdOrder, true>(lds, wid, g, S, E);
    }
    SEAM(14);

    if (IN(15)) {
        pg8::Gemm g{(const bf16_t*)(ws + WS_HID), (const bf16_t*)(ws + W_DOWN), 4096, 4096, 4096}; pg8::StdOrder S; S.init(T, 1024, 4096, 4096, G, bx);
        pg8::EpiRes E{a.out, (const float*)(ws + WS_R2), (const float*)(ws + WS_STAT2), (const float*)a.in[I_LN2G], (const float*)a.in[I_LN2B]};
        pg8::gemm_phase<pg8::EpiRes, pg8::StdOrder, true>(lds, wid, g, S, E);
    }
    SEAM(15);

    if (IN(16)) {
        IDS();
        for (int m = gw; m < T; m += NGW) ln_row(a.out + (size_t)m * D, (const float*)a.in[I_LN3G], (const float*)a.in[I_LN3B], nullptr, a.out + (size_t)m * D, nullptr, lane);
    }
#undef IN
#undef SEAM
}

constexpr int NPHASES = 17;
#ifndef N_LAUNCH_MODE
#define N_LAUNCH_MODE 0
#endif

extern "C" void kernel_launch(void* const* d_in, const int* in_sizes, int n_in, void* d_out, int out_size, void* d_ws, size_t ws_size, hipStream_t stream) {
    static int grid = 0;
    if (grid == 0) {
        if (n_in != 33 || out_size != T * D || ws_size < WS_END) { fprintf(stderr, "kernel_launch: unexpected problem (n_in %d, out %d, ws %zu)\n", n_in, out_size, ws_size); grid = -1; return; }
        int dev = 0, cus = 0, per_cu = 0;
        (void)hipGetDevice(&dev); (void)hipDeviceGetAttribute(&cus, hipDeviceAttributeMultiprocessorCount, dev);
        if (hipFuncSetAttribute((const void*)fwd_kernel, hipFuncAttributeMaxDynamicSharedMemorySize, LDS_BYTES) != hipSuccess) { fprintf(stderr, "kernel_launch: hipFuncSetAttribute failed\n"); grid = -1; return; }
        if (hipOccupancyMaxActiveBlocksPerMultiprocessor(&per_cu, (const void*)fwd_kernel, NTHREADS, LDS_BYTES) != hipSuccess || per_cu < 1) { fprintf(stderr, "kernel_launch: occupancy query gave %d\n", per_cu); per_cu = 1; }
        (void)hipGetLastError();
        grid = cus;
        fprintf(stderr, "kernel_launch: grid %d (occupancy query %d per CU)\n", grid, per_cu);
    }
    if (grid < 0) return;
    if (hipMemsetAsync(d_ws, 0, 256, stream) != hipSuccess) { fprintf(stderr, "kernel_launch: memset failed\n"); return; }
    Args a{};
    for (int i = 0; i < 33; ++i) a.in[i] = d_in[i];
    a.out = (float*)d_out; a.ws = (unsigned char*)d_ws;
#if N_LAUNCH_MODE == 0
    a.ph_lo = 0; a.ph_hi = NPHASES; a.coop = 1;
    void* args[] = {&a};
    hipError_t e = hipLaunchCooperativeKernel((const void*)fwd_kernel, dim3(grid), dim3(NTHREADS), args, LDS_BYTES, stream);
    if (e != hipSuccess) fprintf(stderr, "kernel_launch: cooperative launch failed: %s\n", hipGetErrorString(e));
#else
    for (int p = 0; p < NPHASES; ++p) { a.ph_lo = p; a.ph_hi = p + 1; a.coop = 0;
        hipLaunchKernelGGL(fwd_kernel, dim3(grid), dim3(NTHREADS), LDS_BYTES, stream, a); }
#endif
}
```
